# Optimizing an MI355X kernel written in HIP

```python
import math
import jax, jax.numpy as jnp
from jax import lax
import numpy as np


D_MODEL = 1024
BATCH = 2
SEQ = 16384
DEPTH = 2

HEAD_DIM = 64
GRID_W = 64
QBLOCK = 128
ROPE_THETA = 10000.0
RMS_EPS = 1e-6
A_Q_HEADS = 8
A_KV_HEADS = 2
B_GROUPS = ((128, 1), (512, 4), (2048, 16))
B_HEADS_PER_GROUP = 4
C_HEADS = 16
NA_ROWS = 8
NA_COLS = 16
MLP_HIDDEN = 4 * D_MODEL

N_EVEN = (DEPTH + 1) // 2
N_ODD = DEPTH // 2
A_Q_W = A_Q_HEADS * HEAD_DIM
A_KV_W = A_KV_HEADS * HEAD_DIM
B_W = len(B_GROUPS) * B_HEADS_PER_GROUP * HEAD_DIM
AB_IN = A_Q_W + 2 * A_KV_W + 3 * B_W
AB_OUT = A_Q_W + B_HEADS_PER_GROUP * HEAD_DIM
C_W = C_HEADS * HEAD_DIM
C_IN = 3 * C_W

kernel_name = 'hybrid_axial_gqa_dilated_neighbourhood_encoder'


def rms_norm(x, g):
    xf = x.astype(jnp.float32)
    y = xf * lax.rsqrt(jnp.mean(xf * xf, axis=-1, keepdims=True) + RMS_EPS)
    return (y * g.astype(jnp.float32)).astype(x.dtype)


def rope_cos_sin(pos, dim):
    inv_freq = ROPE_THETA ** (-jnp.arange(0, dim, 2, dtype=jnp.float32) / dim)
    ang = pos.astype(jnp.float32)[:, None] * inv_freq[None, :]
    return jnp.cos(ang), jnp.sin(ang)


def apply_rope(x, cos, sin):
    xf = x.astype(jnp.float32)
    x1, x2 = jnp.split(xf, 2, axis=-1)
    return jnp.concatenate([x1 * cos - x2 * sin, x2 * cos + x1 * sin], axis=-1).astype(x.dtype)


def apply_axial_rope(x, row_cs, col_cs):
    half = x.shape[-1] // 2
    return jnp.concatenate([apply_rope(x[..., :half], *row_cs),
                            apply_rope(x[..., half:], *col_cs)], axis=-1)


def dense_gqa_attention(q, k, v):
    b, hkv, g, s, dh = q.shape
    nb = s // QBLOCK
    scale = 1.0 / math.sqrt(dh)
    qb = jnp.moveaxis(q.reshape(b, hkv, g, nb, QBLOCK, dh), 3, 0)

    def one_block(q_blk):
        sc = jnp.einsum('bkgqd,bksd->bkgqs', q_blk, k, preferred_element_type=jnp.float32) * scale
        p = jax.nn.softmax(sc, axis=-1)
        return jnp.einsum('bkgqs,bksd->bkgqd', p.astype(v.dtype), v)

    o = lax.map(one_block, qb)
    return jnp.moveaxis(o, 0, 3).reshape(b, hkv * g, s, dh)


def gathered_attention(q, k, v, idx, extra, score_mod):
    b, h, s, dh = q.shape
    nk = idx.shape[-1]
    nb = s // QBLOCK
    scale = 1.0 / math.sqrt(dh)
    qb = jnp.moveaxis(q.reshape(b, h, nb, QBLOCK, dh), 2, 0)
    ib = idx.reshape(nb, QBLOCK, nk)
    eb = extra.reshape(nb, QBLOCK, nk)

    def one_block(args):
        q_blk, i_blk, e_blk = args
        kg = jnp.take(k, i_blk, axis=2)
        vg = jnp.take(v, i_blk, axis=2)
        sc = jnp.einsum('bhqd,bhqkd->bhqk', q_blk, kg, preferred_element_type=jnp.float32) * scale
        sc = score_mod(sc, e_blk)
        m = jnp.max(sc, axis=-1, keepdims=True)
        p = jnp.exp(sc - m)
        l = jnp.sum(p, axis=-1, keepdims=True)
        o = jnp.einsum('bhqk,bhqkd->bhqd', (p / l).astype(vg.dtype), vg)
        return o, (m + jnp.log(l))[..., 0]

    o, lse = lax.map(one_block, (qb, ib, eb))
    o = jnp.moveaxis(o, 0, 2).reshape(b, h, s, dh)
    lse = jnp.moveaxis(lse, 0, 2).reshape(b, h, s)
    return o, lse


def dilated_indices(s, window, dilation):
    half = window // (2 * dilation)
    off = dilation * jnp.arange(-half, half + 1, dtype=jnp.int32)
    pos = jnp.arange(s, dtype=jnp.int32)[:, None] + off[None, :]
    valid = (pos >= 0) & (pos < s)
    return jnp.clip(pos, 0, s - 1), valid


def neighbourhood_indices(s):
    rows = s // GRID_W
    wh = min(NA_ROWS, rows)
    t = jnp.arange(s, dtype=jnp.int32)
    r, c = t // GRID_W, t % GRID_W
    rs = jnp.clip(r - wh // 2, 0, rows - wh)
    cs = jnp.clip(c - NA_COLS // 2, 0, GRID_W - NA_COLS)
    kr = rs[:, None] + jnp.arange(wh, dtype=jnp.int32)[None, :]
    kc = cs[:, None] + jnp.arange(NA_COLS, dtype=jnp.int32)[None, :]
    idx = (kr[:, :, None] * GRID_W + kc[:, None, :]).reshape(s, wh * NA_COLS)
    dr = kr - r[:, None] + (NA_ROWS - 1)
    dc = kc - c[:, None] + (NA_COLS - 1)
    bidx = (dr[:, :, None] * (2 * NA_COLS - 1) + dc[:, None, :]).reshape(s, wh * NA_COLS)
    return idx, bidx


def mask_mod(sc, valid):
    return jnp.where(valid[None, None], sc, -jnp.inf)


def mixer_ab(h, w_in, w_out, q_gain, k_gain):
    b, s, _ = h.shape
    proj = h @ w_in
    p1 = A_Q_W
    p2 = p1 + A_KV_W
    p3 = p2 + A_KV_W
    p4 = p3 + B_W
    p5 = p4 + B_W
    qa, ka, va, qb, kb, vb = jnp.split(proj, [p1, p2, p3, p4, p5], axis=-1)
    t = jnp.arange(s, dtype=jnp.int32)

    grp = A_Q_HEADS // A_KV_HEADS
    qa = qa.reshape(b, s, A_KV_HEADS, grp, HEAD_DIM).transpose(0, 2, 3, 1, 4)
    ka = ka.reshape(b, s, A_KV_HEADS, HEAD_DIM).transpose(0, 2, 1, 3)
    va = va.reshape(b, s, A_KV_HEADS, HEAD_DIM).transpose(0, 2, 1, 3)
    row_cs = rope_cos_sin(t // GRID_W, HEAD_DIM // 2)
    col_cs = rope_cos_sin(t % GRID_W, HEAD_DIM // 2)
    qa = apply_axial_rope(rms_norm(qa, q_gain), row_cs, col_cs)
    ka = apply_axial_rope(rms_norm(ka, k_gain), row_cs, col_cs)
    oa = dense_gqa_attention(qa, ka, va)

    n_g = len(B_GROUPS)

    def heads(z):
        return z.reshape(b, s, n_g, B_HEADS_PER_GROUP, HEAD_DIM).transpose(2, 0, 3, 1, 4)

    cs1 = rope_cos_sin(t, HEAD_DIM)
    qb = apply_rope(heads(qb), *cs1)
    kb = apply_rope(heads(kb), *cs1)
    vb = heads(vb)
    outs, lses = [], []
    for gi, (window, dil) in enumerate(B_GROUPS):
        idx, valid = dilated_indices(s, window, dil)
        o_g, lse_g = gathered_attention(qb[gi], kb[gi], vb[gi], idx, valid, mask_mod)
        outs.append(o_g.astype(jnp.float32))
        lses.append(lse_g)
    wts = jax.nn.softmax(jnp.stack(lses, axis=0), axis=0)
    ob = jnp.sum(wts[..., None] * jnp.stack(outs, axis=0), axis=0).astype(h.dtype)

    o = jnp.concatenate([oa, ob], axis=1)
    return o.transpose(0, 2, 1, 3).reshape(b, s, AB_OUT) @ w_out


def mixer_c(h, w_in, w_out, rpb):
    b, s, _ = h.shape
    q, k, v = jnp.split(h @ w_in, 3, axis=-1)
    q, k, v = [z.reshape(b, s, C_HEADS, HEAD_DIM).transpose(0, 2, 1, 3) for z in (q, k, v)]
    idx, bidx = neighbourhood_indices(s)
    table = rpb.reshape(C_HEADS, -1).astype(jnp.float32)
    o, _ = gathered_attention(q, k, v, idx, bidx, lambda sc, e: sc + table[:, e][None])
    return o.transpose(0, 2, 1, 3).reshape(b, s, C_W) @ w_out


def sq_relu_mlp(h, w_up, w_down):
    return jnp.square(jax.nn.relu(h @ w_up)) @ w_down


def sandwich(x, mod, g_pre, g_post, fn):
    shift, scale, gate = jnp.split(mod[:, None, :], 3, axis=-1)
    h = rms_norm(x, g_pre) * (1 + scale) + shift
    return x + gate * rms_norm(fn(h), g_post)


def setup_inputs(seed: int = 0) -> dict:
    key = jax.random.key(seed)
    ks = jax.random.split(key, 14)
    D = D_MODEL

    def normal(k, shape, std):
        return jax.random.normal(k, shape, jnp.float32) * std

    return {
        'x': normal(ks[0], (BATCH, SEQ, D), 1.0),
        'c': normal(ks[1], (BATCH, D), 1.0),
        'ada_w': normal(ks[2], (DEPTH, 2, D, 3 * D), D ** -0.5),
        'ada_b': normal(ks[3], (DEPTH, 2, 3 * D), 0.02),
        'norm_g': 1.0 + normal(ks[4], (DEPTH, 4, D), 0.1),
        'ab_w_in': normal(ks[5], (N_EVEN, D, AB_IN), D ** -0.5),
        'ab_w_out': normal(ks[6], (N_EVEN, AB_OUT, D), AB_OUT ** -0.5),
        'a_q_gain': 1.0 + normal(ks[7], (N_EVEN, HEAD_DIM), 0.1),
        'a_k_gain': 1.0 + normal(ks[8], (N_EVEN, HEAD_DIM), 0.1),
        'c_w_in': normal(ks[9], (N_ODD, D, C_IN), D ** -0.5),
        'c_w_out': normal(ks[10], (N_ODD, C_W, D), C_W ** -0.5),
        'c_rpb': normal(ks[11], (N_ODD, C_HEADS, 2 * NA_ROWS - 1, 2 * NA_COLS - 1), 0.1),
        'mlp_w_up': normal(ks[12], (DEPTH, D, MLP_HIDDEN), D ** -0.5),
        'mlp_w_down': normal(ks[13], (DEPTH, MLP_HIDDEN, D), MLP_HIDDEN ** -0.5),
    }


def reference(x, c, ada_w, ada_b, norm_g, ab_w_in, ab_w_out, a_q_gain, a_k_gain,
              c_w_in, c_w_out, c_rpb, mlp_w_up, mlp_w_down):
    cond = jax.nn.silu(c)
    for layer in range(DEPTH):
        mod_mix = cond @ ada_w[layer, 0] + ada_b[layer, 0]
        mod_mlp = cond @ ada_w[layer, 1] + ada_b[layer, 1]
        i = layer // 2
        if layer % 2 == 0:
            mix = functools_partial_ab(ab_w_in[i], ab_w_out[i], a_q_gain[i], a_k_gain[i])
        else:
            mix = functools_partial_c(c_w_in[i], c_w_out[i], c_rpb[i])
        x = sandwich(x, mod_mix, norm_g[layer, 0], norm_g[layer, 1], mix)
        x = sandwich(x, mod_mlp, norm_g[layer, 2], norm_g[layer, 3],
                     lambda h, wu=mlp_w_up[layer], wd=mlp_w_down[layer]: sq_relu_mlp(h, wu, wd))
    return x


def functools_partial_ab(w_in, w_out, q_gain, k_gain):
    return lambda h: mixer_ab(h, w_in, w_out, q_gain, k_gain)


def functools_partial_c(w_in, w_out, rpb):
    return lambda h: mixer_c(h, w_in, w_out, rpb)
```

```cpp
#include <hip/hip_runtime.h>
#include <hip/hip_cooperative_groups.h>
#include <cstdio>
#include <cstdint>
namespace cg = cooperative_groups;
namespace pg8 {
#define PG8_LAS __attribute__((address_space(3)))
typedef unsigned short bf16_t;
typedef short bf16x8 __attribute__((ext_vector_type(8)));
typedef float f32x4 __attribute__((ext_vector_type(4)));
typedef unsigned u32x4 __attribute__((ext_vector_type(4)));
constexpr int BM = 256, BK = 64, HALF = 128, HTB = HALF * BK * 2  , STAGE_BYTES = 8 * HTB, NXCD = 8, WGM = 8;

__host__ __device__ __forceinline__ int lds_byte(int r, int c) { const int st = (r >> 4) * 2 + (c >> 5), rr = r & 15, cc = c & 31, ob = rr * 64 + cc * 2; return st * 1024 + (ob ^ (((ob >> 9) & 1) << 5)); }
__host__ __device__ __forceinline__ void stage_rc(int b, int& R, int& C) { const int st = b / 1024, sb = b % 1024, swz = sb ^ (((sb >> 9) & 1) << 5); R = (st >> 1) * 16 + swz / 64; C = (st & 1) * 32 + (swz % 64) / 2; }
__host__ __device__ __forceinline__ int perm32(int rho) { const int n = rho >> 4, i = rho & 15; return 8 * (i >> 2) + 4 * n + (i & 3); }

struct Unit { int pm, pn; };
struct Gemm { const bf16_t* A; const bf16_t* Bt; int M, N, K; };

struct StaticOrder {
    int nM, nN, nwg, G, c;
    __host__ __device__ void init(int M, int N, int G_, int c_) { nM = M / BM; nN = N / BM; nwg = nM * nN; G = G_; c = c_; }
    __host__ __device__ bool next(int i, Unit& u) const {
        const long L = (long)i * G + c; if (L >= nwg) return false;
        int wgid = (int)L; { const int q = nwg / NXCD, r = nwg % NXCD, xcd = wgid % NXCD, off = wgid / NXCD; wgid = (xcd < r ? xcd * (q + 1) : r * (q + 1) + (xcd - r) * q) + off; }
        const int nig = WGM * nN, gid = wgid / nig, fm = gid * WGM, gsz = (nM - fm) < WGM ? (nM - fm) : WGM;
        u.pm = fm + ((wgid % nig) % gsz); u.pn = (wgid % nig) / gsz; return true;
    }
    __device__ __forceinline__ void a_ready(const Unit&) const {}
    __device__ __forceinline__ void done(const Unit&) const {}
};

__device__ __forceinline__ unsigned cvt_pk_bf16(float lo, float hi) { unsigned r; asm volatile("v_cvt_pk_bf16_f32 %0, %1, %2" : "=v"(r) : "v"(lo), "v"(hi)); return r; }
typedef float f32x2 __attribute__((ext_vector_type(2)));

template <int ACT  > struct EpiBf16 {
    static constexpr bool PERM = true, AFTER_DRAIN = false;
    bf16_t* O; int ldc;
    __device__ __forceinline__ void operator()(const f32x4 (&acc)[2][2][4][2], const Unit& u, int wr, int wc, int fr, int fq) const {
        const int row0 = u.pm * BM + wr * 64 + fr; const int col0 = u.pn * BM + wc * 32 + 8 * fq;
#pragma unroll
        for (int ai = 0; ai < 2; ++ai)
#pragma unroll
            for (int m = 0; m < 4; ++m) { bf16_t* rowp = O + (size_t)(row0 + ai * HALF + m * 16) * ldc + col0;
#pragma unroll
                for (int bj = 0; bj < 2; ++bj) { f32x4 v0 = acc[ai][bj][m][0], v1 = acc[ai][bj][m][1];
                    if (ACT == 2) {
#pragma unroll
                        for (int e = 0; e < 4; ++e) { const float a = fmaxf(v0[e], 0.f), b = fmaxf(v1[e], 0.f); v0[e] = a * a; v1[e] = b * b; } }
                    u32x4 w; w.x = cvt_pk_bf16(v0[0], v0[1]); w.y = cvt_pk_bf16(v0[2], v0[3]); w.z = cvt_pk_bf16(v1[0], v1[1]); w.w = cvt_pk_bf16(v1[2], v1[3]);
                    *(u32x4*)(rowp + bj * HALF) = w; } }
    }
};
struct EpiPrep {
    static constexpr bool PERM = false, AFTER_DRAIN = false;
    bf16_t* O; int ldc; const float* qgain; const float* kgain; const f32x4* TA; const f32x4* TB; int seq; float qscale, eps;
    static __device__ __forceinline__ void store_row(bf16_t* rowp  , const unsigned (&pk)[2][2][2], int fq) {
        const int off = (fq & 1) ? 12 : 0;
#pragma unroll
        for (int bj = 0; bj < 2; ++bj) {
            const auto r0 = __builtin_amdgcn_permlane16_swap(pk[bj][0][0], pk[bj][1][0], false, false);
            const auto r1 = __builtin_amdgcn_permlane16_swap(pk[bj][0][1], pk[bj][1][1], false, false);
            u32x4 w; w.x = r0[0]; w.y = r1[0]; w.z = r0[1]; w.w = r1[1];
            *(u32x4*)(rowp + 32 * bj + off) = w; }
    }
    __device__ __forceinline__ void operator()(const f32x4 (&acc)[2][2][4][2], const Unit& u, int wr, int wc, int fr, int fq) const {
        const int pn = u.pn;
        int type = 0; float osc = 1.f; const float* gain = qgain;
        if (pn < 2) { type = 1; osc = qscale; } else if (pn == 2) { if (wc < 2) { type = 1; gain = kgain; } } else if (pn < 6) { type = 2; osc = qscale; } else if (pn < 9) { type = 2; }
        const int row0 = u.pm * BM + wr * 64 + fr; const int hcol0 = pn * BM + wc * 64 + 4 * fq;
        if (type == 0) {
#pragma unroll
            for (int ai = 0; ai < 2; ++ai)
#pragma unroll
                for (int m = 0; m < 4; ++m) { bf16_t* rowp = O + (size_t)(row0 + ai * HALF + m * 16) * ldc + hcol0; unsigned pk[2][2][2];
#pragma unroll
                    for (int bj = 0; bj < 2; ++bj)
#pragma unroll
                        for (int n = 0; n < 2; ++n) { const f32x4 v = acc[ai][bj][m][n]; pk[bj][n][0] = cvt_pk_bf16(v[0], v[1]); pk[bj][n][1] = cvt_pk_bf16(v[2], v[3]); }
                    store_row(rowp, pk, fq); }
        } else if (type == 1) {
            f32x4 g[2][2];
#pragma unroll
            for (int bj = 0; bj < 2; ++bj)
#pragma unroll
                for (int n = 0; n < 2; ++n) g[bj][n] = *(const f32x4*)(gain + 32 * bj + 16 * n + 4 * fq);
#pragma unroll
            for (int ai = 0; ai < 2; ++ai)
#pragma unroll
                for (int m = 0; m < 4; ++m) { const int row = row0 + ai * HALF + m * 16; const int t = row & (seq - 1); bf16_t* rowp = O + (size_t)row * ldc + hcol0;
                    const f32x4* tr_ = TA + ((t >> 6) * 16 + 4 * fq) / 2; const f32x4* tc_ = TA + ((t & 63) * 16 + 4 * fq) / 2;
                    f32x4 cs[2][2]; cs[0][0] = tr_[0]; cs[0][1] = tr_[1]; cs[1][0] = tc_[0]; cs[1][1] = tc_[1];
                    float ss = 0.f;
#pragma unroll
                    for (int bj = 0; bj < 2; ++bj)
#pragma unroll
                        for (int n = 0; n < 2; ++n) { const f32x4 v = acc[ai][bj][m][n]; ss += (v[0] * v[0] + v[1] * v[1]) + (v[2] * v[2] + v[3] * v[3]); }
                    ss += __shfl_xor(ss, 16); ss += __shfl_xor(ss, 32);
                    const float rstd = osc / sqrtf(ss * (1.f / 64.f) + eps);
                    unsigned pk[2][2][2];
#pragma unroll
                    for (int bj = 0; bj < 2; ++bj) { const f32x4 y0 = acc[ai][bj][m][0] * g[bj][0] * rstd, y1 = acc[ai][bj][m][1] * g[bj][1] * rstd;
                        const float c0 = cs[bj][0][0], s0 = cs[bj][0][1], c1 = cs[bj][0][2], s1 = cs[bj][0][3], c2 = cs[bj][1][0], s2 = cs[bj][1][1], c3 = cs[bj][1][2], s3 = cs[bj][1][3];
                        pk[bj][0][0] = cvt_pk_bf16(y0[0] * c0 - y1[0] * s0, y0[1] * c1 - y1[1] * s1); pk[bj][0][1] = cvt_pk_bf16(y0[2] * c2 - y1[2] * s2, y0[3] * c3 - y1[3] * s3);
                        pk[bj][1][0] = cvt_pk_bf16(y1[0] * c0 + y0[0] * s0, y1[1] * c1 + y0[1] * s1); pk[bj][1][1] = cvt_pk_bf16(y1[2] * c2 + y0[2] * s2, y1[3] * c3 + y0[3] * s3); }
                    store_row(rowp, pk, fq); }
        } else {
#pragma unroll
            for (int ai = 0; ai < 2; ++ai)
#pragma unroll
                for (int m = 0; m < 4; ++m) { const int row = row0 + ai * HALF + m * 16; const int t = row & (seq - 1); bf16_t* rowp = O + (size_t)row * ldc + hcol0;
                    const f32x4* tb_ = TB + ((size_t)t * 32 + 4 * fq) / 2;
                    f32x4 cs[2][2]; cs[0][0] = tb_[0]; cs[0][1] = tb_[1]; cs[1][0] = tb_[8]; cs[1][1] = tb_[9];
                    unsigned pk[2][2][2];
#pragma unroll
                    for (int n = 0; n < 2; ++n) { const f32x4 x0 = acc[ai][0][m][n] * osc, x1 = acc[ai][1][m][n] * osc;
                        const float c0 = cs[n][0][0], s0 = cs[n][0][1], c1 = cs[n][0][2], s1 = cs[n][0][3], c2 = cs[n][1][0], s2 = cs[n][1][1], c3 = cs[n][1][2], s3 = cs[n][1][3];
                        pk[0][n][0] = cvt_pk_bf16(x0[0] * c0 - x1[0] * s0, x0[1] * c1 - x1[1] * s1); pk[0][n][1] = cvt_pk_bf16(x0[2] * c2 - x1[2] * s2, x0[3] * c3 - x1[3] * s3);
                        pk[1][n][0] = cvt_pk_bf16(x1[0] * c0 + x0[0] * s0, x1[1] * c1 + x0[1] * s1); pk[1][n][1] = cvt_pk_bf16(x1[2] * c2 + x0[2] * s2, x1[3] * c3 + x0[3] * s3); }
                    store_row(rowp, pk, fq); }
        }
    }
};

template <class Epi, class Sched, bool ALIGN_EPI = false, bool SP2 = false>
__device__ __forceinline__ void gemm_phase(PG8_LAS unsigned char* lds, const Gemm g, const Sched& S, const Epi& E) {
    const int tid = threadIdx.x, wid = __builtin_amdgcn_readfirstlane(tid >> 6), lane = tid & 63, wr = wid >> 2, wc = wid & 3, fr = lane & 15, fq = lane >> 4;
    const int K = g.K, nt = K / BK;
    unsigned voffA[2], voffB[2];
#pragma unroll
    for (int i = 0; i < 2; ++i) { int R, C; stage_rc(tid * 16 + i * 8192, R, C); const int Rb = Epi::PERM ? ((R & ~31) + perm32(R & 31)) : R;
        voffA[i] = (unsigned)(R * K + C) * 2u; voffB[i] = (unsigned)(Rb * K + C) * 2u; }
    const size_t kstep = (size_t)(BK * 2);
    const size_t hstep = (size_t)HALF * K * 2;
    const size_t tstep = 2 * hstep;
    const unsigned ldsw = (unsigned)wid * 1024u;
    const int aoff = lds_byte(wr * 64 + fr, fq * 8), boff = lds_byte(wc * 32 + fr, fq * 8);
#define PG8_SA(b, h) (((b) * 2 + (h)) * HTB)
#define PG8_SB(b, h) ((4 + (b) * 2 + (h)) * HTB)
#define PG8_STAGE(bufoff, gbase, voff) do { _Pragma("unroll") for (int _i = 0; _i < 2; ++_i) \
        __builtin_amdgcn_global_load_lds((const unsigned*)((const char*)(gbase) + (voff)[_i]), (PG8_LAS unsigned*)(lds + (bufoff) + ldsw + _i * 8192), 16, 0, 0); } while (0)
#define PG8_LDA(dst, b, h) do { _Pragma("unroll") for (int m = 0; m < 4; ++m) _Pragma("unroll") for (int k = 0; k < 2; ++k) dst[m][k] = *(const PG8_LAS bf16x8*)(lds + PG8_SA(b, h) + aoff + m * 2048 + k * 1024); } while (0)
#define PG8_LDB(dst, b, h) do { _Pragma("unroll") for (int n = 0; n < 2; ++n) _Pragma("unroll") for (int k = 0; k < 2; ++k) dst[n][k] = *(const PG8_LAS bf16x8*)(lds + PG8_SB(b, h) + boff + n * 2048 + k * 1024); } while (0)
#define PG8_MMA(ai, bj, At, Bt) do { __builtin_amdgcn_s_setprio(1); _Pragma("unroll") for (int m = 0; m < 4; ++m) _Pragma("unroll") for (int n = 0; n < 2; ++n) _Pragma("unroll") for (int k = 0; k < 2; ++k) \
        acc[ai][bj][m][n] = __builtin_amdgcn_mfma_f32_16x16x32_bf16(Bt[n][k], At[m][k], acc[ai][bj][m][n], 0, 0, 0); __builtin_amdgcn_s_setprio(0); } while (0)
#define PG8_WAIT_V(n) asm volatile("s_waitcnt vmcnt(" #n ")" ::: "memory")
#define PG8_WAIT_L(n) asm volatile("s_waitcnt lgkmcnt(" #n ")" ::: "memory")
#define PG8_BAR __builtin_amdgcn_s_barrier()
#define PG8_SCHED __builtin_amdgcn_sched_barrier(0)
    Unit cur, nxt; int ui = 0;
    if (!S.next(0, cur)) return;
    f32x4 acc[2][2][4][2];
#pragma unroll
    for (int a = 0; a < 2; ++a)
#pragma unroll
        for (int b = 0; b < 2; ++b)
#pragma unroll
            for (int m = 0; m < 4; ++m)
#pragma unroll
                for (int n = 0; n < 2; ++n) acc[a][b][m][n] = (f32x4){0.f, 0.f, 0.f, 0.f};
    bf16x8 At[4][2], B0[2][2], B1[2][2];
    const char* cA = (const char*)g.A + (size_t)cur.pm * tstep; const char* cB = (const char*)g.Bt + (size_t)cur.pn * tstep;
    S.a_ready(cur);
    if constexpr (SP2) {
        PG8_STAGE(PG8_SB(0, 0), cB, voffB); PG8_STAGE(PG8_SB(0, 1), cB + hstep, voffB); PG8_STAGE(PG8_SA(0, 0), cA, voffA); PG8_STAGE(PG8_SA(0, 1), cA + hstep, voffA);
        if (wr == 1) PG8_BAR;
        PG8_WAIT_V(2); PG8_BAR;
        PG8_STAGE(PG8_SB(1, 0), cB + kstep, voffB); PG8_STAGE(PG8_SA(1, 0), cA + kstep, voffA); PG8_STAGE(PG8_SB(1, 1), cB + hstep + kstep, voffB);
        PG8_WAIT_V(6); PG8_BAR;
    } else {
        PG8_STAGE(PG8_SB(0, 0), cB, voffB); PG8_STAGE(PG8_SA(0, 0), cA, voffA); PG8_STAGE(PG8_SB(0, 1), cB + hstep, voffB); PG8_STAGE(PG8_SA(0, 1), cA + hstep, voffA);
        if (wr == 1) PG8_BAR;
        PG8_WAIT_V(4); PG8_BAR;
        PG8_STAGE(PG8_SB(1, 0), cB + kstep, voffB); PG8_STAGE(PG8_SA(1, 0), cA + kstep, voffA); PG8_STAGE(PG8_SB(1, 1), cB + hstep + kstep, voffB);
        PG8_WAIT_V(6); PG8_BAR;
    }
    for (;;) {
        const bool has_next = S.next(ui + 1, nxt);
        const char* nA = has_next ? (const char*)g.A + (size_t)nxt.pm * tstep : cA; const char* nB = has_next ? (const char*)g.Bt + (size_t)nxt.pn * tstep : cB;
        for (int t = 0; t < nt; t += 2) {
            const bool last = (t == nt - 2);
            const char* a1 = cA + (size_t)(t + 1) * kstep;
            const char* a2 = last ? nA : cA + (size_t)(t + 2) * kstep; const char* b2 = last ? nB : cB + (size_t)(t + 2) * kstep;
            const char* a3 = a2 + kstep; const char* b3 = b2 + kstep;
            if (last && has_next) S.a_ready(nxt);
            if constexpr (SP2) {
            PG8_LDB(B0, 0, 0); PG8_LDB(B1, 0, 1); PG8_SCHED; PG8_LDA(At, 0, 0); PG8_STAGE(PG8_SA(1, 1), a1 + hstep, voffA);
            PG8_WAIT_V(8); PG8_WAIT_L(0); PG8_BAR; PG8_MMA(0, 0, At, B0); PG8_MMA(0, 1, At, B1); PG8_BAR; PG8_SCHED;
            PG8_LDA(At, 0, 1); PG8_STAGE(PG8_SB(0, 0), b2, voffB); PG8_STAGE(PG8_SB(0, 1), b2 + hstep, voffB); PG8_STAGE(PG8_SA(0, 0), a2, voffA);
            PG8_WAIT_V(8); PG8_WAIT_L(0); PG8_BAR; PG8_MMA(1, 0, At, B0); PG8_MMA(1, 1, At, B1); PG8_BAR; PG8_SCHED;
            PG8_LDB(B0, 1, 0); PG8_LDB(B1, 1, 1); PG8_SCHED; PG8_LDA(At, 1, 0); PG8_STAGE(PG8_SA(0, 1), a2 + hstep, voffA);
            PG8_WAIT_V(8); PG8_WAIT_L(0); PG8_BAR; PG8_MMA(0, 0, At, B0); PG8_MMA(0, 1, At, B1); PG8_BAR; PG8_SCHED;
            PG8_LDA(At, 1, 1); PG8_STAGE(PG8_SB(1, 0), b3, voffB); PG8_STAGE(PG8_SB(1, 1), b3 + hstep, voffB); PG8_STAGE(PG8_SA(1, 0), a3, voffA);
            PG8_WAIT_V(8); PG8_WAIT_L(0); PG8_BAR; PG8_MMA(1, 0, At, B0); PG8_MMA(1, 1, At, B1); PG8_BAR; PG8_SCHED;
            } else {
            PG8_LDB(B0, 0, 0); PG8_SCHED; PG8_LDA(At, 0, 0); PG8_STAGE(PG8_SA(1, 1), a1 + hstep, voffA);
            PG8_WAIT_L(8); PG8_BAR; PG8_WAIT_L(0); PG8_MMA(0, 0, At, B0); PG8_BAR; PG8_SCHED;
            PG8_LDB(B1, 0, 1); PG8_STAGE(PG8_SB(0, 0), b2, voffB);
            PG8_BAR; PG8_WAIT_L(0); PG8_MMA(0, 1, At, B1); PG8_BAR;
            PG8_LDA(At, 0, 1); PG8_STAGE(PG8_SA(0, 0), a2, voffA);
            PG8_BAR; PG8_WAIT_L(0); PG8_MMA(1, 0, At, B0); PG8_BAR; PG8_SCHED;
            PG8_STAGE(PG8_SB(0, 1), b2 + hstep, voffB);
            PG8_WAIT_V(6); PG8_BAR; PG8_MMA(1, 1, At, B1); PG8_BAR;
            PG8_LDB(B0, 1, 0); PG8_SCHED; PG8_LDA(At, 1, 0); PG8_STAGE(PG8_SA(0, 1), a2 + hstep, voffA);
            PG8_WAIT_L(8); PG8_BAR; PG8_WAIT_L(0); PG8_MMA(0, 0, At, B0); PG8_BAR; PG8_SCHED;
            PG8_LDB(B1, 1, 1); PG8_STAGE(PG8_SB(1, 0), b3, voffB);
            PG8_BAR; PG8_WAIT_L(0); PG8_MMA(0, 1, At, B1); PG8_BAR;
            PG8_LDA(At, 1, 1); PG8_STAGE(PG8_SA(1, 0), a3, voffA);
            PG8_BAR; PG8_WAIT_L(0); PG8_MMA(1, 0, At, B0); PG8_BAR; PG8_SCHED;
            PG8_STAGE(PG8_SB(1, 1), b3 + hstep, voffB);
            PG8_WAIT_V(6); PG8_BAR; PG8_MMA(1, 1, At, B1); PG8_BAR;
            }
        }
        if constexpr (ALIGN_EPI) { if (wr == 0) PG8_BAR; }
        if constexpr (!Epi::AFTER_DRAIN) { E(acc, cur, wr, wc, fr, fq); S.done(cur); }
        if (!has_next) break;
#pragma unroll
        for (int a = 0; a < 2; ++a)
#pragma unroll
            for (int b = 0; b < 2; ++b)
#pragma unroll
                for (int m = 0; m < 4; ++m)
#pragma unroll
                    for (int n = 0; n < 2; ++n) acc[a][b][m][n] = (f32x4){0.f, 0.f, 0.f, 0.f};
        cur = nxt; cA = nA; cB = nB; ++ui;
        if constexpr (ALIGN_EPI) { if (wr == 1) PG8_BAR; }
    }
    PG8_WAIT_V(0);
    if constexpr (!ALIGN_EPI) { if (wr == 0) PG8_BAR; }
    PG8_BAR;
    if constexpr (Epi::AFTER_DRAIN) { E.fused(acc, cur, wr, wc, fr, fq, lds, wid, lane); S.done(cur); }
#undef PG8_SA
#undef PG8_SB
#undef PG8_STAGE
#undef PG8_LDA
#undef PG8_LDB
#undef PG8_MMA
#undef PG8_WAIT_V
#undef PG8_WAIT_L
#undef PG8_BAR
#undef PG8_SCHED
}
}

#ifndef MK_SINGLE
#define MK_SINGLE 1
#endif
#define LAS __attribute__((address_space(3)))
typedef unsigned short bf16;
typedef short v8s __attribute__((ext_vector_type(8)));
typedef short v4s __attribute__((ext_vector_type(4)));
typedef float v16f __attribute__((ext_vector_type(16)));
typedef float v4f __attribute__((ext_vector_type(4)));
typedef float v2f __attribute__((ext_vector_type(2)));
typedef unsigned v4u __attribute__((ext_vector_type(4)));
typedef unsigned v2u __attribute__((ext_vector_type(2)));
constexpr int BATCH = 2, SEQ = 16384, DM = 1024, MROWS = BATCH * SEQ, FF = 4096, PROJ_W = 3072;
constexpr float RMS_EPS = 1e-6f;
constexpr float LOG2E = 1.4426950408889634f;
constexpr float QSCALE = 0.125f * LOG2E;
constexpr size_t MiB = 1u << 20;
constexpr size_t WS_MOD = 0, WS_TA = 128 * 1024, WS_BAR = 256 * 1024, WS_TB = 1 * MiB;
constexpr size_t WS_WABIN = 6 * MiB, WS_WABOUT = 12 * MiB, WS_WCIN = 14 * MiB, WS_WCOUT = 20 * MiB, WS_WUP = 22 * MiB, WS_WDN = 38 * MiB;
constexpr size_t WS_H = 56 * MiB, WS_PROJ = 120 * MiB, WS_HID = 120 * MiB, WS_YMIX = 120 * MiB, WS_ATT = 376 * MiB, WS_OB = 56 * MiB  , WS_LSE = 104 * MiB, WS_YMLP = 376 * MiB, WS_XB = 440 * MiB  , WS_END = 504 * MiB;
constexpr int LDS_BYTES = 131072 + 8192;
constexpr int NPHASE = 20;

struct Args { const float* in[14]; float* out; unsigned char* ws; int ph_lo, ph_hi; };

__device__ __forceinline__ float wave_sum(float v) {
    v += __int_as_float(__builtin_amdgcn_update_dpp(0, __float_as_int(v), 0xB1, 0xF, 0xF, true));
    v += __int_as_float(__builtin_amdgcn_update_dpp(0, __float_as_int(v), 0x4E, 0xF, 0xF, true));
    v += __int_as_float(__builtin_amdgcn_update_dpp(0, __float_as_int(v), 0x141, 0xF, 0xF, true));
    v += __int_as_float(__builtin_amdgcn_update_dpp(0, __float_as_int(v), 0x140, 0xF, 0xF, true));
    const float r0 = __int_as_float(__builtin_amdgcn_readlane(__float_as_int(v), 0)), r1 = __int_as_float(__builtin_amdgcn_readlane(__float_as_int(v), 16));
    const float r2 = __int_as_float(__builtin_amdgcn_readlane(__float_as_int(v), 32)), r3 = __int_as_float(__builtin_amdgcn_readlane(__float_as_int(v), 48));
    return (r0 + r1) + (r2 + r3);
}
__device__ __forceinline__ unsigned cvtpk(float lo, float hi) { typedef __bf16 bf16x2_t __attribute__((ext_vector_type(2))); v2f v = {lo, hi}; bf16x2_t b = __builtin_convertvector(v, bf16x2_t); return __builtin_bit_cast(unsigned, b); }
__device__ __forceinline__ float bf2f(bf16 v) { return __uint_as_float(((unsigned)v) << 16); }
__device__ __forceinline__ bf16 f2bf(float f) { return (bf16)(cvtpk(f, 0.f) & 0xffffu); }

struct P0Item { const float* W; bf16* WT; int K, N, item; bool hperm; };
__device__ __forceinline__ void p0_load(const P0Item& I, float (&wv)[32], int lane) {
    const int nblk = I.N / 32, kb = I.item / nblk, nb = I.item % nblk, k0 = 64 * kb, n0 = 32 * nb;
#pragma unroll
    for (int i = 0; i < 32; ++i) { const int kk = 2 * i + (lane >> 5); wv[i] = I.W[(size_t)(k0 + kk) * I.N + n0 + (lane & 31)]; }
}
__device__ __forceinline__ void p0_finish(const P0Item& I, const float (&wv)[32], LAS float* scr, int lane) {
    const int nblk = I.N / 32, kb = I.item / nblk, nb = I.item % nblk, k0 = 64 * kb, n0 = 32 * nb;
#pragma unroll
    for (int i = 0; i < 32; ++i) { const int kk = 2 * i + (lane >> 5); scr[kk * 33 + (lane & 31)] = wv[i]; }
    asm volatile("s_waitcnt lgkmcnt(0)" ::: "memory");
    const int c = lane & 7;
#pragma unroll
    for (int j = 0; j < 4; ++j) { const int n = (lane >> 3) + 8 * j; const LAS float* sp = scr + (8 * c) * 33 + n;
        v4u o; o.x = cvtpk(sp[0 * 33], sp[1 * 33]); o.y = cvtpk(sp[2 * 33], sp[3 * 33]); o.z = cvtpk(sp[4 * 33], sp[5 * 33]); o.w = cvtpk(sp[6 * 33], sp[7 * 33]);
        int nd = n0 + n; if (I.hperm) nd = (nd & ~255) | ((nd & 32) << 2) | ((nd & 192) >> 1) | (nd & 31);
        *(v4u*)(I.WT + (size_t)nd * I.K + k0 + 8 * c) = o; }
    asm volatile("s_waitcnt lgkmcnt(0)" ::: "memory");
}
__device__ __forceinline__ v2f sincos_red(float ang) {
    const float n = rintf(ang * 0.15915494309189535f);
    float r = fmaf(-n, 6.2831854820251465f, ang);
    r = fmaf(-n, -1.7484556000744883e-07f, r);
    const float fr = r * 0.15915494309189535f;
    v2f o; o.x = __builtin_amdgcn_cosf(fr); o.y = __builtin_amdgcn_sinf(fr); return o;
}
__device__ __forceinline__ void phase_prologue(const Args& a, LAS unsigned char* lds, int tid, int lane, int wave, int G) {
    LAS float* cond = (LAS float*)lds;
    LAS float* red = (LAS float*)(lds + 8192);
    const float* c = a.in[1];
    for (int i = tid; i < 2048; i += 512) { const float v = c[i]; cond[i] = v / (1.f + __expf(-v)); }
    __syncthreads();
    const float* adaw = a.in[2]; const float* adab = a.in[3]; float* mod = (float*)(a.ws + WS_MOD);
    for (int it = blockIdx.x; it < 384; it += G) {
        const int lj = it / 96, n0 = (it % 96) * 32, kg = tid >> 5, cn = tid & 31;
        const float* W = adaw + (size_t)lj * 1024 * 3072 + n0 + cn;
        float a0 = 0.f, a1 = 0.f;
#pragma unroll 32
        for (int k = kg; k < 1024; k += 16) { const float wv = W[(size_t)k * 3072]; a0 += cond[k] * wv; a1 += cond[1024 + k] * wv; }
        red[(kg * 32 + cn) * 2] = a0; red[(kg * 32 + cn) * 2 + 1] = a1;
        __syncthreads();
        if (tid < 64) { const int cn2 = tid & 31, b = tid >> 5; float s = 0.f;
#pragma unroll
            for (int g = 0; g < 16; ++g) s += red[(g * 32 + cn2) * 2 + b];
            mod[((size_t)lj * 2 + b) * 3072 + n0 + cn2] = s + adab[lj * 3072 + n0 + cn2]; }
        __syncthreads();
    }
    v2f* TA = (v2f*)(a.ws + WS_TA); v2f* TB = (v2f*)(a.ws + WS_TB);
    const int gt = blockIdx.x * 512 + tid, NT_ = G * 512;
    for (int i = gt; i < 256 * 16; i += NT_) { const int pos = i >> 4, f = i & 15; const float inv = exp2f(-(float)(2 * f) * (13.287712379549449f / 32.f)); TA[i] = sincos_red((float)pos * inv); }
    for (int i = gt; i < SEQ * 32; i += NT_) { const int pos = i >> 5, f = i & 31; const float inv = exp2f(-(float)(2 * f) * (13.287712379549449f / 64.f)); TB[i] = sincos_red((float)pos * inv); }
    LAS float* scrA = (LAS float*)(lds + wave * 16896);
    LAS float* scrB = scrA + 64 * 33;
    const int gw = blockIdx.x * 8 + wave, NGW = G * 8;
    constexpr int I_ABIN = 16 * 96, I_ABOUT = 12 * 32, I_CIN = 16 * 96, I_COUT = 16 * 32, I_UP = 16 * 128, I_DN = 64 * 32;
    constexpr int NITEMS = I_ABIN + I_ABOUT + I_CIN + I_COUT + 2 * I_UP + 2 * I_DN;
#define P0_DECODE(it_, I_) do { int r_ = (it_); \
        if (r_ < I_ABIN) { I_ = P0Item{a.in[5], (bf16*)(a.ws + WS_WABIN), 1024, 3072, r_, true}; } \
        else if ((r_ -= I_ABIN) < I_ABOUT) { I_ = P0Item{a.in[6], (bf16*)(a.ws + WS_WABOUT), 768, 1024, r_, false}; } \
        else if ((r_ -= I_ABOUT) < I_CIN) { I_ = P0Item{a.in[9], (bf16*)(a.ws + WS_WCIN), 1024, 3072, r_, false}; } \
        else if ((r_ -= I_CIN) < I_COUT) { I_ = P0Item{a.in[10], (bf16*)(a.ws + WS_WCOUT), 1024, 1024, r_, false}; } \
        else if ((r_ -= I_COUT) < 2 * I_UP) { const int l_ = r_ / I_UP; I_ = P0Item{a.in[12] + (size_t)l_ * 1024 * 4096, (bf16*)(a.ws + WS_WUP + (size_t)l_ * 8 * MiB), 1024, 4096, r_ % I_UP, false}; } \
        else { r_ -= 2 * I_UP; const int l_ = r_ / I_DN; I_ = P0Item{a.in[13] + (size_t)l_ * 4096 * 1024, (bf16*)(a.ws + WS_WDN + (size_t)l_ * 8 * MiB), 4096, 1024, r_ % I_DN, false}; } } while (0)
    for (int it = gw; it < NITEMS; it += 2 * NGW) {
        P0Item IA, IB; float wa[32], wb[32];
        const bool hasB = it + NGW < NITEMS;
        P0_DECODE(it, IA); p0_load(IA, wa, lane);
        if (hasB) { P0_DECODE(it + NGW, IB); p0_load(IB, wb, lane); }
        p0_finish(IA, wa, scrA, lane);
        if (hasB) p0_finish(IB, wb, scrB, lane);
    }
#undef P0_DECODE
}

template <bool XIN16, bool XOUT16>
__device__ __forceinline__ void rows_phase(const void* xin_, void* xout_, const bf16* Y, const float* gpost, const float* gmod,
                                           bf16* H, const float* gpre, const float* nmod, int gw, int NGW, int lane) {
    constexpr int R = 4;
    for (int m0 = gw; m0 < MROWS; m0 += R * NGW) {
        v4f x[R][4]; v2u yr[R][4];
#pragma unroll
        for (int r = 0; r < R; ++r) { const size_t m = (size_t)(m0 + r * NGW);
#pragma unroll
            for (int j = 0; j < 4; ++j) {
                if (XIN16) { const v2u xr = ((const v2u*)((const bf16*)xin_ + m * DM))[lane + 64 * j];
                    x[r][j].x = __uint_as_float(xr.x << 16); x[r][j].y = __uint_as_float(xr.x & 0xffff0000u); x[r][j].z = __uint_as_float(xr.y << 16); x[r][j].w = __uint_as_float(xr.y & 0xffff0000u); }
                else x[r][j] = ((const v4f*)((const float*)xin_ + m * DM))[lane + 64 * j];
                if (Y) yr[r][j] = ((const v2u*)(Y + m * DM))[lane + 64 * j]; } }
        int bcur = m0 / SEQ;
        v4f gg[4], gp[4], sh[4];
#define ROWS_PARAMS(b_) do { _Pragma("unroll") for (int j = 0; j < 4; ++j) { const int col = 4 * (lane + 64 * j); \
            if (Y) gg[j] = *(const v4f*)(gmod + (b_) * 3072 + 2048 + col) * *(const v4f*)(gpost + col); \
            if (H) { gp[j] = *(const v4f*)(gpre + col) * (*(const v4f*)(nmod + (b_) * 3072 + 1024 + col) + 1.0f); sh[j] = *(const v4f*)(nmod + (b_) * 3072 + col); } } } while (0)
        ROWS_PARAMS(bcur);
#pragma unroll
        for (int r = 0; r < R; ++r) { const int m = m0 + r * NGW; const int b = m / SEQ;
            if (b != bcur) { bcur = b; ROWS_PARAMS(bcur); }
            if (Y) {
                v4f y[4]; float ss = 0.f;
#pragma unroll
                for (int j = 0; j < 4; ++j) { y[j].x = __uint_as_float(yr[r][j].x << 16); y[j].y = __uint_as_float(yr[r][j].x & 0xffff0000u); y[j].z = __uint_as_float(yr[r][j].y << 16); y[j].w = __uint_as_float(yr[r][j].y & 0xffff0000u);
                    ss += (y[j].x * y[j].x + y[j].y * y[j].y) + (y[j].z * y[j].z + y[j].w * y[j].w); }
                const float rstd = 1.0f / sqrtf(wave_sum(ss) * (1.f / DM) + RMS_EPS);
#pragma unroll
                for (int j = 0; j < 4; ++j) { x[r][j] = x[r][j] + gg[j] * (y[j] * rstd);
                    if (XOUT16) { v2u o; o.x = cvtpk(x[r][j].x, x[r][j].y); o.y = cvtpk(x[r][j].z, x[r][j].w); ((v2u*)((bf16*)xout_ + (size_t)m * DM))[lane + 64 * j] = o; }
                    else ((v4f*)((float*)xout_ + (size_t)m * DM))[lane + 64 * j] = x[r][j]; }
            }
            if (H) {
                float ss = 0.f;
#pragma unroll
                for (int j = 0; j < 4; ++j) ss += (x[r][j].x * x[r][j].x + x[r][j].y * x[r][j].y) + (x[r][j].z * x[r][j].z + x[r][j].w * x[r][j].w);
                const float rstd = 1.0f / sqrtf(wave_sum(ss) * (1.f / DM) + RMS_EPS);
#pragma unroll
                for (int j = 0; j < 4; ++j) { const v4f hv = x[r][j] * rstd * gp[j] + sh[j]; v2u o; o.x = cvtpk(hv.x, hv.y); o.y = cvtpk(hv.z, hv.w);
                    ((v2u*)(H + (size_t)m * DM))[lane + 64 * j] = o; }
            }
        }
#undef ROWS_PARAMS
    }
}

__device__ __forceinline__ void combine_phase(const Args& a, int gw, int NGW, int lane) {
    const bf16* OB = (const bf16*)(a.ws + WS_OB); const float* LSE = (const float*)(a.ws + WS_LSE); bf16* ATT = (bf16*)(a.ws + WS_ATT);
    const int j = lane >> 4;
    constexpr int R = 4;
    for (int m0 = gw; m0 < MROWS; m0 += R * NGW) {
        float l[R][3]; v2u ov[R][3];
#pragma unroll
        for (int r = 0; r < R; ++r) { const size_t m = (size_t)(m0 + r * NGW);
#pragma unroll
            for (int g = 0; g < 3; ++g) { l[r][g] = LSE[(size_t)g * MROWS * 4 + m * 4 + j]; ov[r][g] = *(const v2u*)(OB + (size_t)g * MROWS * 256 + m * 256 + 4 * lane); } }
#pragma unroll
        for (int r = 0; r < R; ++r) { const size_t m = (size_t)(m0 + r * NGW);
            const float mx = fmaxf(l[r][0], fmaxf(l[r][1], l[r][2]));
            float w[3]; float s_ = 0.f;
#pragma unroll
            for (int g = 0; g < 3; ++g) { w[g] = __builtin_amdgcn_exp2f(l[r][g] - mx); s_ += w[g]; }
            const float inv = 1.0f / s_;
            float acc[4] = {0.f, 0.f, 0.f, 0.f};
#pragma unroll
            for (int g = 0; g < 3; ++g) { const float wg = w[g] * inv;
                acc[0] += wg * __uint_as_float(ov[r][g].x << 16); acc[1] += wg * __uint_as_float(ov[r][g].x & 0xffff0000u);
                acc[2] += wg * __uint_as_float(ov[r][g].y << 16); acc[3] += wg * __uint_as_float(ov[r][g].y & 0xffff0000u); }
            v2u o; o.x = cvtpk(acc[0], acc[1]); o.y = cvtpk(acc[2], acc[3]);
            *(v2u*)(ATT + m * 768 + 512 + 4 * lane) = o; }
    }
}

constexpr int ARS = 144, ATILE = 64 * ARS, ABUF = 2 * ATILE;
struct AUnit {
    const bf16* Q; const bf16* K; const bf16* V; int pitch;
    int q_base, q_stride, k_base, k_stride, k_idx0, k_len, nt;
    bf16* O; int o_pitch; float* lse;
    int r0, kr0; const float* rpb;
};
typedef short v4i16_t __attribute__((ext_vector_type(4)));
__device__ __forceinline__ v4s vtr(const LAS unsigned char* p) { return __builtin_bit_cast(v4s, __builtin_amdgcn_ds_read_tr16_b64_v4i16((LAS v4i16_t*)p)); }
__device__ __forceinline__ float half_max(float v) { auto rr = __builtin_amdgcn_permlane32_swap(__float_as_uint(v), __float_as_uint(v), false, false); return fmaxf(__uint_as_float(rr[0]), __uint_as_float(rr[1])); }
__device__ __forceinline__ float half_sum(float v) { auto rr = __builtin_amdgcn_permlane32_swap(__float_as_uint(v), __float_as_uint(v), false, false); return __uint_as_float(rr[0]) + __uint_as_float(rr[1]); }
#define MFMA32(a, b, c) __builtin_amdgcn_mfma_f32_32x32x16_bf16((a), (b), (c), 0, 0, 0)
__device__ __forceinline__ float max3f(float a, float b, float c) { float r; asm("v_max3_f32 %0, %1, %2, %3" : "=v"(r) : "v"(a), "v"(b), "v"(c)); return r; }

__device__ __forceinline__ void store_o_row(bf16* orow, const v16f& o0, const v16f& o1, float inv, int h) {
#pragma unroll
    for (int b = 0; b < 2; ++b)
#pragma unroll
        for (int p = 0; p < 2; ++p) {
            const int ge = 8 * p, go = 8 * p + 4;
            unsigned e0, e1, x0, x1;
            if (b == 0) { e0 = cvtpk(o0[ge] * inv, o0[ge + 1] * inv); e1 = cvtpk(o0[ge + 2] * inv, o0[ge + 3] * inv); x0 = cvtpk(o0[go] * inv, o0[go + 1] * inv); x1 = cvtpk(o0[go + 2] * inv, o0[go + 3] * inv); }
            else        { e0 = cvtpk(o1[ge] * inv, o1[ge + 1] * inv); e1 = cvtpk(o1[ge + 2] * inv, o1[ge + 3] * inv); x0 = cvtpk(o1[go] * inv, o1[go + 1] * inv); x1 = cvtpk(o1[go + 2] * inv, o1[go + 3] * inv); }
            const auto r0 = __builtin_amdgcn_permlane32_swap(e0, x0, false, false);
            const auto r1 = __builtin_amdgcn_permlane32_swap(e1, x1, false, false);
            v4u w; w.x = r0[0]; w.y = r1[0]; w.z = r0[1]; w.w = r1[1];
            *(v4u*)(orow + 32 * b + 16 * p + 8 * h) = w; }
}

template <int MODE>
__device__ __forceinline__ void attn_unit(LAS unsigned char* lds, const AUnit& U) {
    int tid_l = threadIdx.x; asm volatile("" : "+v"(tid_l));
    const int tid = tid_l, lane = tid & 63, w = __builtin_amdgcn_readfirstlane(tid >> 6), q = lane & 31, h = lane >> 5;
    const int sj = tid >> 3, sc = tid & 7;
    const int qi = 32 * w + q;
    const size_t qtok = (size_t)(U.q_base + U.q_stride * qi);
    v8s qr[4];
#pragma unroll
    for (int d0 = 0; d0 < 4; ++d0) qr[d0] = *(const v8s*)(U.Q + qtok * U.pitch + 16 * d0 + 8 * h);
    LAS float* bias = (LAS float*)(lds + 3 * ABUF);
    v4u kst[2], vst[2];
#define GLOAD(t, S_) do { int kidx_ = U.k_idx0 + 64 * (t) + sj; kidx_ = kidx_ < 0 ? 0 : (kidx_ >= U.k_len ? U.k_len - 1 : kidx_); const size_t off_ = (size_t)(U.k_base + U.k_stride * kidx_) * U.pitch + sc * 8; \
        kst[S_] = *(const v4u*)(U.K + off_); vst[S_] = *(const v4u*)(U.V + off_); } while (0)
#define LWRITE(buf, S_) do { *(LAS v4u*)(lds + (buf) * ABUF + sj * ARS + sc * 16) = kst[S_]; *(LAS v4u*)(lds + (buf) * ABUF + ATILE + sj * ARS + sc * 16) = vst[S_]; } while (0)
    GLOAD(0, 0);
    if (U.nt > 1) GLOAD(1, 1);
    __syncthreads();
    if (MODE == 2) { for (int i = tid; i < 465; i += 512) bias[i] = U.rpb[i] * LOG2E; }
    LWRITE(0, 0);
    if (U.nt > 2) GLOAD(2, 0);
    v16f o0, o1;
#pragma unroll
    for (int i = 0; i < 16; ++i) { o0[i] = 0.f; o1[i] = 0.f; }
    float m_run = (MODE == 0) ? 0.f : -1e30f, l_run = 0.f;
    v16f negm;
#pragma unroll
    for (int i = 0; i < 16; ++i) negm[i] = 0.f;
    const int piq = (q & 0x13) | ((q & 4) << 1) | ((q & 8) >> 1);
    const int koff = piq * ARS + 16 * h;
    const int i16 = lane & 15, tq = i16 >> 2, tp = i16 & 3, blk = (lane >> 4) & 1;
    const int voff = (8 * h + tq) * ARS + 32 * blk + 8 * tp;
    const int nr = U.r0 + (w >> 1), nc = 32 * (w & 1) + q;
    const int nrs = nr - 4 < 0 ? 0 : (nr - 4 > 248 ? 248 : nr - 4);
    const int ncs = nc - 8 < 0 ? 0 : (nc - 8 > 48 ? 48 : nc - 8);
    v8s kf0[4], kf1[4];
#define KLOAD(base) do { _Pragma("unroll") for (int d0_ = 0; d0_ < 4; ++d0_) { kf0[d0_] = *(const LAS v8s*)((base) + koff + d0_ * 32); kf1[d0_] = *(const LAS v8s*)((base) + 32 * ARS + koff + d0_ * 32); } } while (0)
    __syncthreads();
    KLOAD(lds);
    if (U.nt > 1) LWRITE(1, 1);
    int bcur = 0;
    for (int t0 = 0; t0 < U.nt; t0 += 2) {
#pragma unroll
      for (int u_ = 0; u_ < 2; ++u_) {
        const int t = t0 + u_;
        if (t < U.nt) {
        __syncthreads();
        if (t + 3 < U.nt) GLOAD(t + 3, u_ ^ 1);
        const int bnext = bcur == 2 ? 0 : bcur + 1, bnn = bnext == 2 ? 0 : bnext + 1;
        const LAS unsigned char* vt = lds + bcur * ABUF + ATILE;
        bool active = true;
        if (MODE == 1) { const int k0t = U.k_idx0 + 64 * t; active = (t >= (w >> 1)) && (t <= (w >> 1) + 2) && (k0t >= 0) && (k0t < U.k_len); }
        if (MODE == 2) { const int kr = U.kr0 + t; active = (kr >= nrs) && (kr < nrs + 8); }
        if (active) {
            v16f p0, p1;
            if (MODE == 0) { p0 = negm; p1 = negm; }
            else {
#pragma unroll
                for (int i = 0; i < 16; ++i) { p0[i] = 0.f; p1[i] = 0.f; } }
#pragma unroll
            for (int d0 = 0; d0 < 4; ++d0) { p0 = MFMA32(kf0[d0], qr[d0], p0); p1 = MFMA32(kf1[d0], qr[d0], p1); }
            if (t + 1 < U.nt) KLOAD(lds + bnext * ABUF);
            if (MODE == 1) {
                const int tau = t - (w >> 1), qq = 32 * (w & 1) + q - 8 * h;
                if (tau == 0) {
#pragma unroll
                    for (int i = 0; i < 16; ++i) { const int jj = 16 * (i >> 3) + (i & 7); p0[i] = (jj >= qq) ? p0[i] : -INFINITY; p1[i] = (jj + 32 >= qq) ? p1[i] : -INFINITY; }
                } else if (tau == 2) {
#pragma unroll
                    for (int i = 0; i < 16; ++i) { const int jj = 16 * (i >> 3) + (i & 7); p0[i] = (jj <= qq) ? p0[i] : -INFINITY; p1[i] = (jj + 32 <= qq) ? p1[i] : -INFINITY; }
                }
            }
            if (MODE == 2) {
                const int kr = U.kr0 + t; const int rowoff = (kr - nr + 7) * 31 + 15 - nc;
#pragma unroll
                for (int i = 0; i < 16; ++i) { const int kc = 8 * h + 16 * (i >> 3) + (i & 7);
                    const bool ok0 = (unsigned)(kc - ncs) < 16u, ok1 = (unsigned)(kc + 32 - ncs) < 16u;
                    const float b0 = bias[ok0 ? rowoff + kc : 0], b1 = bias[ok1 ? rowoff + kc + 32 : 0];
                    p0[i] = ok0 ? fmaf(p0[i], QSCALE, b0) : -INFINITY; p1[i] = ok1 ? fmaf(p1[i], QSCALE, b1) : -INFINITY; }
            }
            if (MODE == 3) {
                float rs = 0.f;
#pragma unroll
                for (int i = 0; i < 16; ++i) { p0[i] = __builtin_amdgcn_exp2f(p0[i]); p1[i] = __builtin_amdgcn_exp2f(p1[i]); rs += p0[i] + p1[i]; }
                l_run += rs;
            } else if (MODE == 0) {
                float ma = max3f(p0[0], p0[1], p1[0]), mb = max3f(p0[2], p0[3], p1[1]); ma = max3f(ma, p1[2], p1[3]);
#pragma unroll
                for (int i = 4; i < 16; i += 4) { ma = max3f(ma, p0[i], p0[i + 1]); mb = max3f(mb, p0[i + 2], p0[i + 3]); ma = max3f(ma, p1[i], p1[i + 1]); mb = max3f(mb, p1[i + 2], p1[i + 3]); }
                const float mx = half_max(fmaxf(ma, mb));
                if (t == 0 || __any(mx > 8.0f)) {
                    const float dl = (t == 0) ? mx : fmaxf(mx, 0.f);
                    const float alpha = (t == 0) ? 1.0f : __builtin_amdgcn_exp2f(-dl);
                    m_run += dl;
#pragma unroll
                    for (int i = 0; i < 16; ++i) { p0[i] -= dl; p1[i] -= dl; o0[i] *= alpha; o1[i] *= alpha; negm[i] = -m_run; }
                    l_run *= alpha;
                }
                float rs = 0.f;
#pragma unroll
                for (int i = 0; i < 16; ++i) { p0[i] = __builtin_amdgcn_exp2f(p0[i]); p1[i] = __builtin_amdgcn_exp2f(p1[i]); rs += p0[i] + p1[i]; }
                l_run += rs;
            } else {
            float mx = fmaxf(p0[0], p1[0]);
#pragma unroll
            for (int i = 1; i < 16; ++i) mx = fmaxf(mx, fmaxf(p0[i], p1[i]));
            mx = half_max(mx);
            const float m_new = fmaxf(m_run, mx);
            const float alpha = __builtin_amdgcn_exp2f(m_run - m_new);
            m_run = m_new;
            float rs = 0.f;
#pragma unroll
            for (int i = 0; i < 16; ++i) { p0[i] = __builtin_amdgcn_exp2f(p0[i] - m_new); p1[i] = __builtin_amdgcn_exp2f(p1[i] - m_new); rs += p0[i] + p1[i]; }
            l_run = l_run * alpha + rs;
            if (__any(alpha != 1.0f)) {
#pragma unroll
                for (int i = 0; i < 16; ++i) { o0[i] *= alpha; o1[i] *= alpha; }
            }
            }
#pragma unroll
            for (int kb = 0; kb < 2; ++kb)
#pragma unroll
                for (int s = 0; s < 2; ++s) {
                    v4u pw;
                    if (kb == 0) { pw.x = cvtpk(p0[8 * s], p0[8 * s + 1]); pw.y = cvtpk(p0[8 * s + 2], p0[8 * s + 3]); pw.z = cvtpk(p0[8 * s + 4], p0[8 * s + 5]); pw.w = cvtpk(p0[8 * s + 6], p0[8 * s + 7]); }
                    else         { pw.x = cvtpk(p1[8 * s], p1[8 * s + 1]); pw.y = cvtpk(p1[8 * s + 2], p1[8 * s + 3]); pw.z = cvtpk(p1[8 * s + 4], p1[8 * s + 5]); pw.w = cvtpk(p1[8 * s + 6], p1[8 * s + 7]); }
                    const v8s pf = __builtin_bit_cast(v8s, pw);
                    const LAS unsigned char* vp = vt + (32 * kb + 16 * s) * ARS + voff;
                    const v4s lo0 = vtr(vp), hi0 = vtr(vp + 4 * ARS), lo1 = vtr(vp + 64), hi1 = vtr(vp + 4 * ARS + 64);
                    const v8s vf0 = __builtin_shufflevector(lo0, hi0, 0, 1, 2, 3, 4, 5, 6, 7), vf1 = __builtin_shufflevector(lo1, hi1, 0, 1, 2, 3, 4, 5, 6, 7);
                    o0 = MFMA32(vf0, pf, o0); o1 = MFMA32(vf1, pf, o1);
                }
        }
        else if (t + 1 < U.nt) KLOAD(lds + bnext * ABUF);
        if (t + 2 < U.nt) LWRITE(bnn, u_);
        bcur = bnext;
        }
      }
    }
#undef GLOAD
#undef LWRITE
#undef KLOAD
    l_run = half_sum(l_run);
    const float inv = 1.0f / l_run;
    bf16* orow = U.O + qtok * U.o_pitch;
    store_o_row(orow, o0, o1, inv, h);
    if (MODE == 1) { if (h == 0) U.lse[qtok * 4] = m_run + __log2f(l_run); }
}

__device__ __forceinline__ void attn_unit_dense64(LAS unsigned char* lds, const AUnit& U) {
    int tid_l = threadIdx.x; asm volatile("" : "+v"(tid_l));
    const int tid = tid_l, lane = tid & 63, w = __builtin_amdgcn_readfirstlane(tid >> 6), q = lane & 31, h = lane >> 5;
    const int sj = tid >> 3, sc = tid & 7;
    const size_t qtokA = (size_t)(U.q_base + 64 * w + q), qtokB = qtokA + 32;
    v8s qa[4], qb[4];
#pragma unroll
    for (int d0 = 0; d0 < 4; ++d0) { qa[d0] = *(const v8s*)(U.Q + qtokA * U.pitch + 16 * d0 + 8 * h); qb[d0] = *(const v8s*)(U.Q + qtokB * U.pitch + 16 * d0 + 8 * h); }
    v4u kreg, vreg;
    const bf16* kg = U.K + (size_t)sj * U.pitch + sc * 8; const bf16* vg = U.V + (size_t)sj * U.pitch + sc * 8;
    const size_t tstride = (size_t)64 * U.pitch;
#define GLOADP(t) do { kreg = *(const v4u*)(kg + (size_t)(t) * tstride); vreg = *(const v4u*)(vg + (size_t)(t) * tstride); } while (0)
#define LWRITEP(buf) do { *(LAS v4u*)(lds + (buf) * ABUF + sj * ARS + sc * 16) = kreg; *(LAS v4u*)(lds + (buf) * ABUF + ATILE + sj * ARS + sc * 16) = vreg; } while (0)
    const int piq = (q & 0x13) | ((q & 4) << 1) | ((q & 8) >> 1);
    const int koff = piq * ARS + 16 * h;
    const int i16 = lane & 15, tq = i16 >> 2, tp = i16 & 3, blk = (lane >> 4) & 1;
    const int voff = (8 * h + tq) * ARS + 32 * blk + 8 * tp;
    GLOADP(0);
    __syncthreads();
    LWRITEP(0); GLOADP(1); LWRITEP(1);
    v16f oa0, oa1, ob0, ob1;
#pragma unroll
    for (int i = 0; i < 16; ++i) { oa0[i] = 0.f; oa1[i] = 0.f; ob0[i] = 0.f; ob1[i] = 0.f; }
    float la = 0.f, lb = 0.f;
    int bcur = 0;
    for (int t = 0; t < U.nt; ++t) {
        __syncthreads();
        if (t + 2 < U.nt) GLOADP(t + 2);
        const int bnext = bcur == 2 ? 0 : bcur + 1, bnn = bnext == 2 ? 0 : bnext + 1;
        const LAS unsigned char* kt = lds + bcur * ABUF + koff; const LAS unsigned char* vt = lds + bcur * ABUF + ATILE + voff;
        v16f pa0, pa1, pb0, pb1;
#pragma unroll
        for (int i = 0; i < 16; ++i) { pa0[i] = 0.f; pa1[i] = 0.f; pb0[i] = 0.f; pb1[i] = 0.f; }
#pragma unroll
        for (int d0 = 0; d0 < 4; ++d0) {
            const v8s k0 = *(const LAS v8s*)(kt + d0 * 32), k1 = *(const LAS v8s*)(kt + 32 * ARS + d0 * 32);
            pa0 = MFMA32(k0, qa[d0], pa0); pa1 = MFMA32(k1, qa[d0], pa1); pb0 = MFMA32(k0, qb[d0], pb0); pb1 = MFMA32(k1, qb[d0], pb1);
        }
        float ra = 0.f, rb = 0.f;
#pragma unroll
        for (int i = 0; i < 16; ++i) { pa0[i] = __builtin_amdgcn_exp2f(pa0[i]); pa1[i] = __builtin_amdgcn_exp2f(pa1[i]); ra += pa0[i] + pa1[i];
                                       pb0[i] = __builtin_amdgcn_exp2f(pb0[i]); pb1[i] = __builtin_amdgcn_exp2f(pb1[i]); rb += pb0[i] + pb1[i]; }
        la += ra; lb += rb;
#pragma unroll
        for (int kb = 0; kb < 2; ++kb)
#pragma unroll
            for (int s_ = 0; s_ < 2; ++s_) {
                v4u wa, wb;
                if (kb == 0) { wa.x = cvtpk(pa0[8 * s_], pa0[8 * s_ + 1]); wa.y = cvtpk(pa0[8 * s_ + 2], pa0[8 * s_ + 3]); wa.z = cvtpk(pa0[8 * s_ + 4], pa0[8 * s_ + 5]); wa.w = cvtpk(pa0[8 * s_ + 6], pa0[8 * s_ + 7]);
                               wb.x = cvtpk(pb0[8 * s_], pb0[8 * s_ + 1]); wb.y = cvtpk(pb0[8 * s_ + 2], pb0[8 * s_ + 3]); wb.z = cvtpk(pb0[8 * s_ + 4], pb0[8 * s_ + 5]); wb.w = cvtpk(pb0[8 * s_ + 6], pb0[8 * s_ + 7]); }
                else         { wa.x = cvtpk(pa1[8 * s_], pa1[8 * s_ + 1]); wa.y = cvtpk(pa1[8 * s_ + 2], pa1[8 * s_ + 3]); wa.z = cvtpk(pa1[8 * s_ + 4], pa1[8 * s_ + 5]); wa.w = cvtpk(pa1[8 * s_ + 6], pa1[8 * s_ + 7]);
                               wb.x = cvtpk(pb1[8 * s_], pb1[8 * s_ + 1]); wb.y = cvtpk(pb1[8 * s_ + 2], pb1[8 * s_ + 3]); wb.z = cvtpk(pb1[8 * s_ + 4], pb1[8 * s_ + 5]); wb.w = cvtpk(pb1[8 * s_ + 6], pb1[8 * s_ + 7]); }
                const v8s pfa = __builtin_bit_cast(v8s, wa), pfb = __builtin_bit_cast(v8s, wb);
                const LAS unsigned char* vp = vt + (32 * kb + 16 * s_) * ARS;
                const v4s lo0 = vtr(vp), hi0 = vtr(vp + 4 * ARS), lo1 = vtr(vp + 64), hi1 = vtr(vp + 4 * ARS + 64);
                const v8s vf0 = __builtin_shufflevector(lo0, hi0, 0, 1, 2, 3, 4, 5, 6, 7), vf1 = __builtin_shufflevector(lo1, hi1, 0, 1, 2, 3, 4, 5, 6, 7);
                oa0 = MFMA32(vf0, pfa, oa0); oa1 = MFMA32(vf1, pfa, oa1); ob0 = MFMA32(vf0, pfb, ob0); ob1 = MFMA32(vf1, pfb, ob1);
            }
        if (t + 2 < U.nt) LWRITEP(bnn);
        bcur = bnext;
    }
#undef GLOADP
#undef LWRITEP
    la = half_sum(la); lb = half_sum(lb);
    const float ia = 1.0f / la, ib = 1.0f / lb;
    bf16* orA = U.O + qtokA * U.o_pitch; bf16* orB = U.O + qtokB * U.o_pitch;
    store_o_row(orA, oa0, oa1, ia, h); store_o_row(orB, ob0, ob1, ib, h);
}

__device__ __forceinline__ void attn_unit_na(LAS unsigned char* lds, const AUnit& U) {
    int tid_l = threadIdx.x; asm volatile("" : "+v"(tid_l));
    const int tid = tid_l, lane = tid & 63, w = __builtin_amdgcn_readfirstlane(tid >> 6), q = lane & 31, h = lane >> 5;
    const int sj = tid >> 3, sc = tid & 7;
    const int rp = w >> 2, cg = w & 3;
    const int ra = U.r0 + 2 * rp, nr = ra + (q >> 4), nc = 16 * cg + (q & 15);
    const int kc0 = cg == 0 ? 0 : (cg == 1 ? 8 : (cg == 2 ? 24 : 32));
    const size_t qtok = (size_t)(nr * 64 + nc);
    v8s qr[4];
#pragma unroll
    for (int d0 = 0; d0 < 4; ++d0) qr[d0] = *(const v8s*)(U.Q + qtok * U.pitch + 16 * d0 + 8 * h);
    LAS float* bias = (LAS float*)(lds + 3 * ABUF) + 64;
    v4u kst[2], vst[2];
    const bf16* kg = U.K + (size_t)(U.k_base + sj) * U.pitch + sc * 8; const bf16* vg = U.V + (size_t)(U.k_base + sj) * U.pitch + sc * 8;
    const size_t tstride = (size_t)64 * U.pitch;
#define GLOADP(t, S_) do { kst[S_] = *(const v4u*)(kg + (size_t)(t) * tstride); vst[S_] = *(const v4u*)(vg + (size_t)(t) * tstride); } while (0)
#define LWRITEP(buf, S_) do { *(LAS v4u*)(lds + (buf) * ABUF + sj * ARS + sc * 16) = kst[S_]; *(LAS v4u*)(lds + (buf) * ABUF + ATILE + sj * ARS + sc * 16) = vst[S_]; } while (0)
    const int piq = (q & 0x13) | ((q & 4) << 1) | ((q & 8) >> 1);
    const int koff = (kc0 + piq) * ARS + 16 * h;
    const int i16 = lane & 15, tq = i16 >> 2, tp = i16 & 3, blk = (lane >> 4) & 1;
    const int voff = (kc0 + 8 * h + tq) * ARS + 32 * blk + 8 * tp;
    const int nrs = nr - 4 < 0 ? 0 : (nr - 4 > 248 ? 248 : nr - 4);
    const int ncs = nc - 8 < 0 ? 0 : (nc - 8 > 48 ? 48 : nc - 8);
    const int wlo = ra - 4 < 0 ? 0 : (ra - 4 > 248 ? 248 : ra - 4), whi = (ra - 3 < 0 ? 0 : (ra - 3 > 248 ? 248 : ra - 3)) + 8;
    GLOADP(0, 0);
    if (U.nt > 1) GLOADP(1, 1);
    __syncthreads();
    for (int i = tid; i < 465 + 128 + 64; i += 512) { const int k = i - 64; bias[k] = (k >= 0 && k < 465) ? U.rpb[k] * LOG2E : (k >= 465 + 64 ? -INFINITY : 0.f); }
    LWRITEP(0, 0);
    if (U.nt > 2) GLOADP(2, 0);
    if (U.nt > 1) LWRITEP(1, 1);
    v16f o0, o1, pen;
#pragma unroll
    for (int i = 0; i < 16; ++i) { o0[i] = 0.f; o1[i] = 0.f; const int kc = kc0 + 8 * h + 16 * (i >> 3) + (i & 7); pen[i] = ((unsigned)(kc - ncs) < 16u) ? 0.f : -INFINITY; }
    const int bbase = 15 - nc + kc0 + 8 * h;
    float m_run = 0.f, l_run = 0.f; bool started = false;
    v16f penm;
#pragma unroll
    for (int i = 0; i < 16; ++i) penm[i] = pen[i];
    int bcur = 0;
    for (int t0 = 0; t0 < U.nt; t0 += 2) {
#pragma unroll
      for (int u_ = 0; u_ < 2; ++u_) {
        const int t = t0 + u_;
        if (t < U.nt) {
        __syncthreads();
        if (t + 3 < U.nt) GLOADP(t + 3, u_ ^ 1);
        const int bnext = bcur == 2 ? 0 : bcur + 1, bnn = bnext == 2 ? 0 : bnext + 1;
        const int kr = U.kr0 + t;
        if (kr >= wlo && kr < whi) {
            const LAS unsigned char* kt = lds + bcur * ABUF + koff; const LAS unsigned char* vt = lds + bcur * ABUF + ATILE + voff;
            v16f p = penm;
#pragma unroll
            for (int d0 = 0; d0 < 4; ++d0) { const v8s k0 = *(const LAS v8s*)(kt + d0 * 32); p = MFMA32(k0, qr[d0], p); }
            const bool rowok = (kr >= nrs) && (kr < nrs + 8);
            int dr = kr - nr + 7; dr = dr < 0 ? 0 : (dr > 14 ? 14 : dr);
            const LAS float* brow = rowok ? bias + dr * 31 + bbase : bias + 465 + 64;
#pragma unroll
            for (int i = 0; i < 16; ++i) p[i] = fmaf(p[i], QSCALE, brow[16 * (i >> 3) + (i & 7)]);
            float ma = max3f(p[0], p[1], p[2]), mb = max3f(p[3], p[4], p[5]);
            ma = max3f(ma, p[6], p[7]); mb = max3f(mb, p[8], p[9]); ma = max3f(ma, p[10], p[11]); mb = max3f(mb, p[12], p[13]); ma = max3f(ma, p[14], p[15]);
            const float mx = half_max(fmaxf(ma, mb));
            const bool need = started ? (mx > 8.0f) : (mx > -INFINITY);
            if (__any(need)) {
                const float dl = need ? (started ? fmaxf(mx, 0.f) : mx) : 0.f;
                const float alpha = (need && started) ? __builtin_amdgcn_exp2f(-dl) : 1.0f;
                m_run += dl; started = started || need;
#pragma unroll
                for (int i = 0; i < 16; ++i) { p[i] -= dl; o0[i] *= alpha; o1[i] *= alpha; penm[i] = (pen[i] - m_run) * (1.0f / QSCALE); }
                l_run *= alpha;
            }
            float rs = 0.f;
#pragma unroll
            for (int i = 0; i < 16; ++i) { p[i] = __builtin_amdgcn_exp2f(p[i]); rs += p[i]; }
            l_run += rs;
#pragma unroll
            for (int s_ = 0; s_ < 2; ++s_) {
                v4u pw; pw.x = cvtpk(p[8 * s_], p[8 * s_ + 1]); pw.y = cvtpk(p[8 * s_ + 2], p[8 * s_ + 3]); pw.z = cvtpk(p[8 * s_ + 4], p[8 * s_ + 5]); pw.w = cvtpk(p[8 * s_ + 6], p[8 * s_ + 7]);
                const v8s pf = __builtin_bit_cast(v8s, pw);
                const LAS unsigned char* vp = vt + (16 * s_) * ARS;
                const v4s lo0 = vtr(vp), hi0 = vtr(vp + 4 * ARS), lo1 = vtr(vp + 64), hi1 = vtr(vp + 4 * ARS + 64);
                const v8s vf0 = __builtin_shufflevector(lo0, hi0, 0, 1, 2, 3, 4, 5, 6, 7), vf1 = __builtin_shufflevector(lo1, hi1, 0, 1, 2, 3, 4, 5, 6, 7);
                o0 = MFMA32(vf0, pf, o0); o1 = MFMA32(vf1, pf, o1);
            }
        }
        if (t + 2 < U.nt) LWRITEP(bnn, u_);
        bcur = bnext;
        }
      }
    }
#undef GLOADP
#undef LWRITEP
    l_run = half_sum(l_run);
    const float inv = 1.0f / l_run;
    bf16* orow = U.O + qtok * U.o_pitch;
    store_o_row(orow, o0, o1, inv, h);
}

__device__ __forceinline__ void attn_phase_l0(const Args& a, LAS unsigned char* lds, int vcu, int G) {
    const bf16* PROJ = (const bf16*)(a.ws + WS_PROJ); bf16* ATT = (bf16*)(a.ws + WS_ATT);
    bool fixedref;
    { const int ln = threadIdx.x & 63; float gq = fabsf(a.in[7][ln]), gk = fabsf(a.in[8][ln]);
#pragma unroll
      for (int o = 1; o < 64; o <<= 1) { gq = fmaxf(gq, __shfl_xor(gq, o)); gk = fmaxf(gk, __shfl_xor(gk, o)); }
      const float bound = 64.f * gq * gk * QSCALE * 1.02f;
      fixedref = __builtin_amdgcn_readfirstlane(bound < 60.f ? 1 : 0) != 0; }
    if (fixedref) {
      const int per = (512 + G - 1) / G;
      for (int i = 0; i < per; ++i) { const int u = vcu * per + i; if (u >= 512) break;
        const int bh = u >> 5, qb = u & 31, b = bh >> 3, hq = bh & 7, kvh = hq >> 2;
        const bf16* base = PROJ + (size_t)b * SEQ * PROJ_W;
        AUnit U; U.Q = base + hq * 64; U.K = base + 512 + kvh * 64; U.V = base + 640 + kvh * 64; U.pitch = PROJ_W;
        U.q_base = 512 * qb; U.q_stride = 1; U.k_base = 0; U.k_stride = 1; U.k_idx0 = 0; U.k_len = SEQ; U.nt = SEQ / 64;
        U.O = ATT + (size_t)b * SEQ * 768 + hq * 64; U.o_pitch = 768; U.lse = nullptr; U.r0 = 0; U.kr0 = 0; U.rpb = nullptr;
        attn_unit_dense64(lds, U); }
    } else {
      const int per = (1024 + G - 1) / G;
      for (int i = 0; i < per; ++i) { const int u = vcu * per + i; if (u >= 1024) break;
        const int bh = u >> 6, qb = u & 63, b = bh >> 3, hq = bh & 7, kvh = hq >> 2;
        const bf16* base = PROJ + (size_t)b * SEQ * PROJ_W;
        AUnit U; U.Q = base + hq * 64; U.K = base + 512 + kvh * 64; U.V = base + 640 + kvh * 64; U.pitch = PROJ_W;
        U.q_base = 256 * qb; U.q_stride = 1; U.k_base = 0; U.k_stride = 1; U.k_idx0 = 0; U.k_len = SEQ; U.nt = SEQ / 64;
        U.O = ATT + (size_t)b * SEQ * 768 + hq * 64; U.o_pitch = 768; U.lse = nullptr; U.r0 = 0; U.kr0 = 0; U.rpb = nullptr;
        attn_unit<0>(lds, U); } }
    { bf16* OB = (bf16*)(a.ws + WS_OB); float* LSE = (float*)(a.ws + WS_LSE);
      const int per = (1536 + G - 1) / G;
      for (int i = 0; i < per; ++i) { const int u = vcu * per + i; if (u >= 1536) break;
        const int uu = u & 63, bgj = u >> 6, j = bgj & 3, g = (bgj >> 2) % 3, b = bgj / 12;
        const int d = g == 0 ? 1 : (g == 1 ? 4 : 16), L = SEQ / d, nb = L / 256, r = uu / nb, i0 = (uu % nb) * 256;
        const bf16* base = PROJ + (size_t)b * SEQ * PROJ_W;
        AUnit U; U.Q = base + 768 + g * 256 + j * 64; U.K = base + 1536 + g * 256 + j * 64; U.V = base + 2304 + g * 256 + j * 64; U.pitch = PROJ_W;
        U.q_base = r + d * i0; U.q_stride = d; U.k_base = r; U.k_stride = d; U.k_idx0 = i0 - 64; U.k_len = L; U.nt = 6;
        U.O = OB + (size_t)g * MROWS * 256 + (size_t)b * SEQ * 256 + j * 64; U.o_pitch = 256; U.lse = LSE + (size_t)g * MROWS * 4 + (size_t)b * SEQ * 4 + j; U.r0 = 0; U.kr0 = 0; U.rpb = nullptr;
        attn_unit<1>(lds, U); } }
}
__device__ __forceinline__ void attn_phase_l1(const Args& a, LAS unsigned char* lds, int vcu, int G) {
    const bf16* PROJ = (const bf16*)(a.ws + WS_PROJ); bf16* ATT = (bf16*)(a.ws + WS_ATT);
    const int per = (2048 + G - 1) / G;
    for (int i = 0; i < per; ++i) { const int u = vcu * per + i; if (u >= 2048) break;
        const int bh = u >> 6, rb = u & 63, b = bh >> 4, hd = bh & 15;
        const bf16* base = PROJ + (size_t)b * SEQ * PROJ_W;
        AUnit U; U.Q = base + hd * 64; U.K = base + 1024 + hd * 64; U.V = base + 2048 + hd * 64; U.pitch = PROJ_W;
        const int r0 = 4 * rb, kr0 = r0 - 4 < 0 ? 0 : (r0 - 4 > 248 ? 248 : r0 - 4), rl = r0 - 1 > 248 ? 248 : r0 - 1;
        U.q_base = 256 * rb; U.q_stride = 1; U.k_base = 64 * kr0; U.k_stride = 1; U.k_idx0 = 0; U.k_len = SEQ; U.nt = (rl < 0 ? 0 : rl) + 8 - kr0;
        U.O = ATT + (size_t)b * SEQ * 1024 + hd * 64; U.o_pitch = 1024; U.lse = nullptr; U.r0 = r0; U.kr0 = kr0; U.rpb = a.in[11] + hd * 465;
        attn_unit_na(lds, U); }
}

#define XB_TMO      128
#define XB_XCNT(j)  (256  + 64 * (j))
#define XB_XSUB(j)  (1280 + 64 * (j))
#define XB_XGEN(j)  (2304 + 64 * (j))
#define XB_TOP      3328
#define XB_TOPGEN   3392
#define XCD_BAR_WORDS 3456
#define XB_SPIN_CAP (1u << 22)

__device__ __forceinline__ unsigned xb_ld(unsigned* p)              { return __hip_atomic_load(p, __ATOMIC_RELAXED, __HIP_MEMORY_SCOPE_AGENT); }
__device__ __forceinline__ unsigned xb_add(unsigned* p, unsigned v) { return __hip_atomic_fetch_add(p, v, __ATOMIC_RELAXED, __HIP_MEMORY_SCOPE_AGENT); }
__device__ __forceinline__ unsigned xb_xcc_id() { return (unsigned)__builtin_amdgcn_s_getreg((3 << 11) | 20) & 0xFu; }
#define XB_SPIN(cond, bar) do { unsigned _sp = 0; while (cond) { __builtin_amdgcn_s_sleep(1); \
    if ((++_sp & 255u) == 0u) { if (xb_ld(&(bar)[XB_TMO])) break; if (_sp > XB_SPIN_CAP) { atomicAdd(&(bar)[XB_TMO], 1u); break; } } } } while (0)

struct XcdBarrier {
    unsigned* bar; unsigned x;
    volatile LAS unsigned* st;
};

__device__ __forceinline__ XcdBarrier xcd_barrier_post(unsigned* bar, volatile LAS unsigned* st) {
    XcdBarrier b; b.bar = bar; b.x = xb_xcc_id(); b.st = st;
    if (threadIdx.x == 0) (void)xb_add(&bar[XB_XCNT(b.x)], 1u);
    return b;
}
__device__ __forceinline__ void xcd_barrier_complete(unsigned* bar, unsigned x, unsigned& nloc, unsigned& nx) {
    const unsigned G = gridDim.x * gridDim.y * gridDim.z;
    unsigned sum, cnt, mine, sp = 0u;
    for (;;) {
        sum = 0u; cnt = 0u; mine = 0u;
#pragma unroll
        for (unsigned j = 0; j < 16; ++j) { const unsigned c = xb_ld(&bar[XB_XCNT(j)]); sum += c; cnt += (c > 0u) ? 1u : 0u; mine = (j == x) ? c : mine; }
        if (sum == G) break;
        __builtin_amdgcn_s_sleep(1);
        if ((++sp & 255u) == 0u) { if (xb_ld(&bar[XB_TMO])) break; if (sp > XB_SPIN_CAP) { atomicAdd(&bar[XB_TMO], 1u); break; } }
    }
    nloc = mine > 0u ? mine : 1u; nx = cnt > 0u ? cnt : 1u;
}

__device__ __forceinline__ void xcd_barrier(const XcdBarrier& b) {
    asm volatile("s_waitcnt vmcnt(0)" ::: "memory");
    __syncthreads();
    if (threadIdx.x == 0) {
        unsigned* bar = b.bar;
        __builtin_amdgcn_s_waitcnt(0);
        unsigned nloc = b.st[0], nx = b.st[1];
        if (nloc == 0u) { xcd_barrier_complete(bar, b.x, nloc, nx); b.st[0] = nloc; b.st[1] = nx; }
        const unsigned old = xb_add(&bar[XB_XSUB(b.x)], 1u);
        const unsigned gen = old / nloc;
        if (old + 1u == (gen + 1u) * nloc) {
            __builtin_amdgcn_fence(__ATOMIC_RELEASE, "agent");
            asm volatile("s_waitcnt vmcnt(0)" ::: "memory");
            const unsigned og = xb_add(&bar[XB_TOP], 1u);
            const unsigned tg = og / nx;
            if (og + 1u == (tg + 1u) * nx) xb_add(&bar[XB_TOPGEN], 1u);
            else XB_SPIN(xb_ld(&bar[XB_TOPGEN]) == tg, bar);
            __builtin_amdgcn_fence(__ATOMIC_ACQUIRE, "agent");
            xb_add(&bar[XB_XGEN(b.x)], 1u);
            asm volatile("s_waitcnt vmcnt(0)" ::: "memory");
        } else {
            XB_SPIN(xb_ld(&bar[XB_XGEN(b.x)]) == gen, bar);
            __builtin_amdgcn_fence(__ATOMIC_ACQUIRE, "agent");
            asm volatile("s_waitcnt vmcnt(0)" ::: "memory");
        }
    }
    __syncthreads();
}

__host__ __device__ __forceinline__ bool phase_empty(int ph) { return ph == 2 + 1 || ph == 2 + 9 + 1 || ph == 2 + 9 + 3; }
template <int PH>
__device__ __forceinline__ void run_phase(const Args& a, LAS unsigned char* lds) {
    const int tid = threadIdx.x, lane = tid & 63, wave = __builtin_amdgcn_readfirstlane(tid >> 6);
    const int G = gridDim.x, bx = blockIdx.x;
    const int vcu = (G % 8 == 0) ? (bx % 8) * (G / 8) + bx / 8 : bx;
    const int gw = bx * 8 + wave, NGW = G * 8;
    float* mod = (float*)(a.ws + WS_MOD); const float* normg = a.in[4];
    bf16* H = (bf16*)(a.ws + WS_H); bf16* PROJ = (bf16*)(a.ws + WS_PROJ); bf16* ATT = (bf16*)(a.ws + WS_ATT); bf16* HID = (bf16*)(a.ws + WS_HID);
    bf16* YMIX = (bf16*)(a.ws + WS_YMIX); bf16* YMLP = (bf16*)(a.ws + WS_YMLP);
    if constexpr (PH == 0) phase_prologue(a, lds, tid, lane, wave, G);
    else if constexpr (PH == 1) rows_phase<false, false>(a.in[0], nullptr, nullptr, nullptr, nullptr, H, normg, mod, gw, NGW, lane);
    else {
        constexpr int l = (PH - 2) / 9, s = (PH - 2) % 9;
        if constexpr (s == 0) {
            pg8::Gemm g{H, (const bf16*)(a.ws + (l == 0 ? WS_WABIN : WS_WCIN)), MROWS, PROJ_W, DM}; pg8::StaticOrder S; S.init(MROWS, PROJ_W, G, bx);
            if constexpr (l == 0) {
                pg8::EpiPrep E{PROJ, PROJ_W, a.in[7], a.in[8], (const pg8::f32x4*)(a.ws + WS_TA), (const pg8::f32x4*)(a.ws + WS_TB), SEQ, QSCALE, RMS_EPS};
                pg8::gemm_phase<pg8::EpiPrep, pg8::StaticOrder, true, true>(lds, g, S, E);
            } else {
                pg8::EpiBf16<0> E{PROJ, PROJ_W};
                pg8::gemm_phase<pg8::EpiBf16<0>, pg8::StaticOrder, true, true>(lds, g, S, E);
            }
        } else if constexpr (s == 1) { }
        else if constexpr (s == 2) { if constexpr (l == 0) attn_phase_l0(a, lds, vcu, G); else attn_phase_l1(a, lds, vcu, G); }
        else if constexpr (s == 3) { if (l == 0) combine_phase(a, gw, NGW, lane); }
        else if constexpr (s == 4) {
            pg8::Gemm g{ATT, (const bf16*)(a.ws + (l == 0 ? WS_WABOUT : WS_WCOUT)), MROWS, DM, l == 0 ? 768 : 1024}; pg8::StaticOrder S; S.init(MROWS, DM, G, bx);
            pg8::EpiBf16<0> E{YMIX, DM};
            pg8::gemm_phase<pg8::EpiBf16<0>, pg8::StaticOrder, true, true>(lds, g, S, E);
        } else if constexpr (s == 5) {
            bf16* XB = (bf16*)(a.ws + WS_XB);
            if constexpr (l == 0) rows_phase<false, true>(a.in[0], XB, YMIX, normg + (l * 4 + 1) * DM, mod + (size_t)(l * 2 + 0) * 2 * 3072, H, normg + (l * 4 + 2) * DM, mod + (size_t)(l * 2 + 1) * 2 * 3072, gw, NGW, lane);
            else rows_phase<true, true>(XB, XB, YMIX, normg + (l * 4 + 1) * DM, mod + (size_t)(l * 2 + 0) * 2 * 3072, H, normg + (l * 4 + 2) * DM, mod + (size_t)(l * 2 + 1) * 2 * 3072, gw, NGW, lane);
        } else if constexpr (s == 6) {
            pg8::Gemm g{H, (const bf16*)(a.ws + WS_WUP + (size_t)l * 8 * MiB), MROWS, FF, DM}; pg8::StaticOrder S; S.init(MROWS, FF, G, bx);
            pg8::EpiBf16<2> E{HID, FF};
            pg8::gemm_phase<pg8::EpiBf16<2>, pg8::StaticOrder, true, true>(lds, g, S, E);
        } else if constexpr (s == 7) {
            pg8::Gemm g{HID, (const bf16*)(a.ws + WS_WDN + (size_t)l * 8 * MiB), MROWS, DM, FF}; pg8::StaticOrder S; S.init(MROWS, DM, G, bx);
            pg8::EpiBf16<0> E{YMLP, DM};
            pg8::gemm_phase<pg8::EpiBf16<0>, pg8::StaticOrder, true, true>(lds, g, S, E);
        } else {
            constexpr bool last = (l == 1);
            bf16* XB = (bf16*)(a.ws + WS_XB);
            if constexpr (last) rows_phase<true, false>(XB, a.out, YMLP, normg + (l * 4 + 3) * DM, mod + (size_t)(l * 2 + 1) * 2 * 3072, nullptr, normg, mod, gw, NGW, lane);
            else rows_phase<true, true>(XB, XB, YMLP, normg + (l * 4 + 3) * DM, mod + (size_t)(l * 2 + 1) * 2 * 3072, H, normg + ((l + 1) * 4 + 0) * DM, mod + (size_t)((l + 1) * 2 + 0) * 2 * 3072, gw, NGW, lane);
        }
    }
}
__global__ void __launch_bounds__(512) fwd(Args a) {
    extern __shared__ __attribute__((aligned(16))) unsigned char lds_raw[];
    LAS unsigned char* lds = (LAS unsigned char*)lds_raw;
    cg::grid_group grid = cg::this_grid();
    const int lo = a.ph_lo, hi = a.ph_hi;
    volatile LAS unsigned* bst = (volatile LAS unsigned*)(lds + 131072 + 4096);
    if (threadIdx.x < 2) bst[threadIdx.x] = 0u;
    __syncthreads();
    XcdBarrier bar; bar.bar = (unsigned*)(a.ws + WS_BAR); bar.x = 0; bar.st = bst;
    if (hi - lo > 1) bar = xcd_barrier_post((unsigned*)(a.ws + WS_BAR), bst);
#define PHASE(k) if (lo <= (k) && (k) < hi) { run_phase<(k)>(a, lds); if ((k) + 1 < hi) { if (hi < 0) grid.sync(); else xcd_barrier(bar); } }
    PHASE(0) PHASE(1) PHASE(2) PHASE(4) PHASE(5) PHASE(6) PHASE(7) PHASE(8) PHASE(9) PHASE(10)
    PHASE(11) PHASE(13) PHASE(15) PHASE(16) PHASE(17) PHASE(18) PHASE(19)
#undef PHASE
}

extern "C" void kernel_launch(void* const* d_in, const int* in_sizes, int n_in, void* d_out, int out_size, void* d_ws, size_t ws_size, hipStream_t stream) {
    static int grid = 0;
    if (grid == 0) {
        if (n_in != 14 || in_sizes[0] != MROWS * DM || out_size != MROWS * DM || ws_size < WS_END) { fprintf(stderr, "kernel_launch: unexpected shapes / workspace (n_in %d, in0 %d, out %d, ws %zu); nothing launched\n", n_in, n_in > 0 ? in_sizes[0] : -1, out_size, ws_size); grid = -1; return; }
        int dev = 0, cus = 0, per_cu = 0;
        if (hipGetDevice(&dev) != hipSuccess || hipDeviceGetAttribute(&cus, hipDeviceAttributeMultiprocessorCount, dev) != hipSuccess) { fprintf(stderr, "kernel_launch: device query failed\n"); grid = -1; return; }
        if (hipFuncSetAttribute((const void*)fwd, hipFuncAttributeMaxDynamicSharedMemorySize, LDS_BYTES) != hipSuccess) { fprintf(stderr, "kernel_launch: hipFuncSetAttribute failed\n"); grid = -1; return; }
        if (hipOccupancyMaxActiveBlocksPerMultiprocessor(&per_cu, (const void*)fwd, 512, LDS_BYTES) != hipSuccess || per_cu < 1) { fprintf(stderr, "kernel_launch: occupancy query says %d\n", per_cu); per_cu = 1; }
        (void)hipGetLastError();
        grid = cus;
    }
    if (grid < 0) return;
    Args a{};
    for (int i = 0; i < 14; ++i) a.in[i] = (const float*)d_in[i];
    a.out = (float*)d_out; a.ws = (unsigned char*)d_ws;
#if MK_SINGLE
    a.ph_lo = 0; a.ph_hi = NPHASE;
    if (hipMemsetAsync((unsigned char*)d_ws + WS_BAR, 0, XCD_BAR_WORDS * 4, stream) != hipSuccess) { fprintf(stderr, "kernel_launch: memset of the barrier words failed\n"); return; }
    void* args[] = {&a};
    hipError_t e = hipLaunchCooperativeKernel((const void*)fwd, dim3(grid), dim3(512), args, LDS_BYTES, stream);
    if (e != hipSuccess) fprintf(stderr, "kernel_launch: cooperative launch failed: %s (grid %d)\n", hipGetErrorString(e), grid);
#else
    for (int ph = 0; ph < NPHASE; ++ph) {
        if (phase_empty(ph)) continue;
        a.ph_lo = ph; a.ph_hi = ph + 1;
        hipLaunchKernelGGL(fwd, dim3(grid), dim3(512), LDS_BYTES, stream, a);
    }
#endif
}
```

```cpp
#include <hip/hip_runtime.h>
#include <hip/hip_cooperative_groups.h>
#include <cstdio>
#include <cstdint>
namespace cg = cooperative_groups;
namespace pg8 {
#define PG8_LAS __attribute__((address_space(3)))
typedef unsigned short bf16_t;
typedef short bf16x8 __attribute__((ext_vector_type(8)));
typedef float f32x4 __attribute__((ext_vector_type(4)));
typedef unsigned u32x4 __attribute__((ext_vector_type(4)));
constexpr int BM = 256, BK = 64, HALF = 128, HTB = HALF * BK * 2  , STAGE_BYTES = 8 * HTB, NXCD = 8, WGM = 8;

__host__ __device__ __forceinline__ int lds_byte(int r, int c) { const int st = (r >> 4) * 2 + (c >> 5), rr = r & 15, cc = c & 31, ob = rr * 64 + cc * 2; return st * 1024 + (ob ^ (((ob >> 9) & 1) << 5)); }
__host__ __device__ __forceinline__ void stage_rc(int b, int& R, int& C) { const int st = b / 1024, sb = b % 1024, swz = sb ^ (((sb >> 9) & 1) << 5); R = (st >> 1) * 16 + swz / 64; C = (st & 1) * 32 + (swz % 64) / 2; }
__host__ __device__ __forceinline__ int perm32(int rho) { const int n = rho >> 4, i = rho & 15; return 8 * (i >> 2) + 4 * n + (i & 3); }

struct Unit { int pm, pn; };
struct Gemm { const bf16_t* A; const bf16_t* Bt; int M, N, K; };

struct StaticOrder {
    int nM, nN, nwg, G, c;
    __host__ __device__ void init(int M, int N, int G_, int c_) { nM = M / BM; nN = N / BM; nwg = nM * nN; G = G_; c = c_; }
    __host__ __device__ bool next(int i, Unit& u) const {
        const long L = (long)i * G + c; if (L >= nwg) return false;
        int wgid = (int)L; { const int q = nwg / NXCD, r = nwg % NXCD, xcd = wgid % NXCD, off = wgid / NXCD; wgid = (xcd < r ? xcd * (q + 1) : r * (q + 1) + (xcd - r) * q) + off; }
        const int nig = WGM * nN, gid = wgid / nig, fm = gid * WGM, gsz = (nM - fm) < WGM ? (nM - fm) : WGM;
        u.pm = fm + ((wgid % nig) % gsz); u.pn = (wgid % nig) / gsz; return true;
    }
    __device__ __forceinline__ void a_ready(const Unit&) const {}
    __device__ __forceinline__ void done(const Unit&) const {}
};

__device__ __forceinline__ unsigned cvt_pk_bf16(float lo, float hi) { unsigned r; asm volatile("v_cvt_pk_bf16_f32 %0, %1, %2" : "=v"(r) : "v"(lo), "v"(hi)); return r; }
typedef float f32x2 __attribute__((ext_vector_type(2)));

template <int ACT  > struct EpiBf16 {
    static constexpr bool PERM = true, AFTER_DRAIN = false;
    bf16_t* O; int ldc;
    __device__ __forceinline__ void operator()(const f32x4 (&acc)[2][2][4][2], const Unit& u, int wr, int wc, int fr, int fq) const {
        const int row0 = u.pm * BM + wr * 64 + fr; const int col0 = u.pn * BM + wc * 32 + 8 * fq;
#pragma unroll
        for (int ai = 0; ai < 2; ++ai)
#pragma unroll
            for (int m = 0; m < 4; ++m) { bf16_t* rowp = O + (size_t)(row0 + ai * HALF + m * 16) * ldc + col0;
#pragma unroll
                for (int bj = 0; bj < 2; ++bj) { f32x4 v0 = acc[ai][bj][m][0], v1 = acc[ai][bj][m][1];
                    if (ACT == 2) {
#pragma unroll
                        for (int e = 0; e < 4; ++e) { const float a = fmaxf(v0[e], 0.f), b = fmaxf(v1[e], 0.f); v0[e] = a * a; v1[e] = b * b; } }
                    u32x4 w; w.x = cvt_pk_bf16(v0[0], v0[1]); w.y = cvt_pk_bf16(v0[2], v0[3]); w.z = cvt_pk_bf16(v1[0], v1[1]); w.w = cvt_pk_bf16(v1[2], v1[3]);
                    *(u32x4*)(rowp + bj * HALF) = w; } }
    }
};
struct EpiPrep {
    static constexpr bool PERM = false, AFTER_DRAIN = false;
    bf16_t* O; int ldc; const float* qgain; const float* kgain; const f32x4* TA; const f32x4* TB; int seq; float qscale, eps;
    static __device__ __forceinline__ void store_row(bf16_t* rowp  , const unsigned (&pk)[2][2][2], int fq) {
        const int off = (fq & 1) ? 12 : 0;
#pragma unroll
        for (int bj = 0; bj < 2; ++bj) {
            const auto r0 = __builtin_amdgcn_permlane16_swap(pk[bj][0][0], pk[bj][1][0], false, false);
            const auto r1 = __builtin_amdgcn_permlane16_swap(pk[bj][0][1], pk[bj][1][1], false, false);
            u32x4 w; w.x = r0[0]; w.y = r1[0]; w.z = r0[1]; w.w = r1[1];
            *(u32x4*)(rowp + 32 * bj + off) = w; }
    }
    __device__ __forceinline__ void operator()(const f32x4 (&acc)[2][2][4][2], const Unit& u, int wr, int wc, int fr, int fq) const {
        const int pn = u.pn;
        int type = 0; float osc = 1.f; const float* gain = qgain;
        if (pn < 2) { type = 1; osc = qscale; } else if (pn == 2) { if (wc < 2) { type = 1; gain = kgain; } } else if (pn < 6) { type = 2; osc = qscale; } else if (pn < 9) { type = 2; }
        const int row0 = u.pm * BM + wr * 64 + fr; const int hcol0 = pn * BM + wc * 64 + 4 * fq;
        if (type == 0) {
#pragma unroll
            for (int ai = 0; ai < 2; ++ai)
#pragma unroll
                for (int m = 0; m < 4; ++m) { bf16_t* rowp = O + (size_t)(row0 + ai * HALF + m * 16) * ldc + hcol0; unsigned pk[2][2][2];
#pragma unroll
                    for (int bj = 0; bj < 2; ++bj)
#pragma unroll
                        for (int n = 0; n < 2; ++n) { const f32x4 v = acc[ai][bj][m][n]; pk[bj][n][0] = cvt_pk_bf16(v[0], v[1]); pk[bj][n][1] = cvt_pk_bf16(v[2], v[3]); }
                    store_row(rowp, pk, fq); }
        } else if (type == 1) {
            f32x4 g[2][2];
#pragma unroll
            for (int bj = 0; bj < 2; ++bj)
#pragma unroll
                for (int n = 0; n < 2; ++n) g[bj][n] = *(const f32x4*)(gain + 32 * bj + 16 * n + 4 * fq);
#pragma unroll
            for (int ai = 0; ai < 2; ++ai)
#pragma unroll
                for (int m = 0; m < 4; ++m) { const int row = row0 + ai * HALF + m * 16; const int t = row & (seq - 1); bf16_t* rowp = O + (size_t)row * ldc + hcol0;
                    const f32x4* tr_ = TA + ((t >> 6) * 16 + 4 * fq) / 2; const f32x4* tc_ = TA + ((t & 63) * 16 + 4 * fq) / 2;
                    f32x4 cs[2][2]; cs[0][0] = tr_[0]; cs[0][1] = tr_[1]; cs[1][0] = tc_[0]; cs[1][1] = tc_[1];
                    float ss = 0.f;
#pragma unroll
                    for (int bj = 0; bj < 2; ++bj)
#pragma unroll
                        for (int n = 0; n < 2; ++n) { const f32x4 v = acc[ai][bj][m][n]; ss += (v[0] * v[0] + v[1] * v[1]) + (v[2] * v[2] + v[3] * v[3]); }
                    ss += __shfl_xor(ss, 16); ss += __shfl_xor(ss, 32);
                    const float rstd = osc / sqrtf(ss * (1.f / 64.f) + eps);
                    unsigned pk[2][2][2];
#pragma unroll
                    for (int bj = 0; bj < 2; ++bj) { const f32x4 y0 = acc[ai][bj][m][0] * g[bj][0] * rstd, y1 = acc[ai][bj][m][1] * g[bj][1] * rstd;
                        const float c0 = cs[bj][0][0], s0 = cs[bj][0][1], c1 = cs[bj][0][2], s1 = cs[bj][0][3], c2 = cs[bj][1][0], s2 = cs[bj][1][1], c3 = cs[bj][1][2], s3 = cs[bj][1][3];
                        pk[bj][0][0] = cvt_pk_bf16(y0[0] * c0 - y1[0] * s0, y0[1] * c1 - y1[1] * s1); pk[bj][0][1] = cvt_pk_bf16(y0[2] * c2 - y1[2] * s2, y0[3] * c3 - y1[3] * s3);
                        pk[bj][1][0] = cvt_pk_bf16(y1[0] * c0 + y0[0] * s0, y1[1] * c1 + y0[1] * s1); pk[bj][1][1] = cvt_pk_bf16(y1[2] * c2 + y0[2] * s2, y1[3] * c3 + y0[3] * s3); }
                    store_row(rowp, pk, fq); }
        } else {
#pragma unroll
            for (int ai = 0; ai < 2; ++ai)
#pragma unroll
                for (int m = 0; m < 4; ++m) { const int row = row0 + ai * HALF + m * 16; const int t = row & (seq - 1); bf16_t* rowp = O + (size_t)row * ldc + hcol0;
                    const f32x4* tb_ = TB + ((size_t)t * 32 + 4 * fq) / 2;
                    f32x4 cs[2][2]; cs[0][0] = tb_[0]; cs[0][1] = tb_[1]; cs[1][0] = tb_[8]; cs[1][1] = tb_[9];
                    unsigned pk[2][2][2];
#pragma unroll
                    for (int n = 0; n < 2; ++n) { const f32x4 x0 = acc[ai][0][m][n] * osc, x1 = acc[ai][1][m][n] * osc;
                        const float c0 = cs[n][0][0], s0 = cs[n][0][1], c1 = cs[n][0][2], s1 = cs[n][0][3], c2 = cs[n][1][0], s2 = cs[n][1][1], c3 = cs[n][1][2], s3 = cs[n][1][3];
                        pk[0][n][0] = cvt_pk_bf16(x0[0] * c0 - x1[0] * s0, x0[1] * c1 - x1[1] * s1); pk[0][n][1] = cvt_pk_bf16(x0[2] * c2 - x1[2] * s2, x0[3] * c3 - x1[3] * s3);
                        pk[1][n][0] = cvt_pk_bf16(x1[0] * c0 + x0[0] * s0, x1[1] * c1 + x0[1] * s1); pk[1][n][1] = cvt_pk_bf16(x1[2] * c2 + x0[2] * s2, x1[3] * c3 + x0[3] * s3); }
                    store_row(rowp, pk, fq); }
        }
    }
};

template <class Epi, class Sched, bool ALIGN_EPI = false, bool SP2 = false>
__device__ __forceinline__ void gemm_phase(PG8_LAS unsigned char* lds, const Gemm g, const Sched& S, const Epi& E) {
    const int tid = threadIdx.x, wid = __builtin_amdgcn_readfirstlane(tid >> 6), lane = tid & 63, wr = wid >> 2, wc = wid & 3, fr = lane & 15, fq = lane >> 4;
    const int K = g.K, nt = K / BK;
    unsigned voffA[2], voffB[2];
#pragma unroll
    for (int i = 0; i < 2; ++i) { int R, C; stage_rc(tid * 16 + i * 8192, R, C); const int Rb = Epi::PERM ? ((R & ~31) + perm32(R & 31)) : R;
        voffA[i] = (unsigned)(R * K + C) * 2u; voffB[i] = (unsigned)(Rb * K + C) * 2u; }
    const size_t kstep = (size_t)(BK * 2);
    const size_t hstep = (size_t)HALF * K * 2;
    const size_t tstep = 2 * hstep;
    const unsigned ldsw = (unsigned)wid * 1024u;
    const int aoff = lds_byte(wr * 64 + fr, fq * 8), boff = lds_byte(wc * 32 + fr, fq * 8);
#define PG8_SA(b, h) (((b) * 2 + (h)) * HTB)
#define PG8_SB(b, h) ((4 + (b) * 2 + (h)) * HTB)
#define PG8_STAGE(bufoff, gbase, voff) do { _Pragma("unroll") for (int _i = 0; _i < 2; ++_i) \
        __builtin_amdgcn_global_load_lds((const unsigned*)((const char*)(gbase) + (voff)[_i]), (PG8_LAS unsigned*)(lds + (bufoff) + ldsw + _i * 8192), 16, 0, 0); } while (0)
#define PG8_LDA(dst, b, h) do { _Pragma("unroll") for (int m = 0; m < 4; ++m) _Pragma("unroll") for (int k = 0; k < 2; ++k) dst[m][k] = *(const PG8_LAS bf16x8*)(lds + PG8_SA(b, h) + aoff + m * 2048 + k * 1024); } while (0)
#define PG8_LDB(dst, b, h) do { _Pragma("unroll") for (int n = 0; n < 2; ++n) _Pragma("unroll") for (int k = 0; k < 2; ++k) dst[n][k] = *(const PG8_LAS bf16x8*)(lds + PG8_SB(b, h) + boff + n * 2048 + k * 1024); } while (0)
#define PG8_MMA(ai, bj, At, Bt) do { __builtin_amdgcn_s_setprio(1); _Pragma("unroll") for (int m = 0; m < 4; ++m) _Pragma("unroll") for (int n = 0; n < 2; ++n) _Pragma("unroll") for (int k = 0; k < 2; ++k) \
        acc[ai][bj][m][n] = __builtin_amdgcn_mfma_f32_16x16x32_bf16(Bt[n][k], At[m][k], acc[ai][bj][m][n], 0, 0, 0); __builtin_amdgcn_s_setprio(0); } while (0)
#define PG8_WAIT_V(n) asm volatile("s_waitcnt vmcnt(" #n ")" ::: "memory")
#define PG8_WAIT_L(n) asm volatile("s_waitcnt lgkmcnt(" #n ")" ::: "memory")
#define PG8_BAR __builtin_amdgcn_s_barrier()
#define PG8_SCHED __builtin_amdgcn_sched_barrier(0)
    Unit cur, nxt; int ui = 0;
    if (!S.next(0, cur)) return;
    f32x4 acc[2][2][4][2];
#pragma unroll
    for (int a = 0; a < 2; ++a)
#pragma unroll
        for (int b = 0; b < 2; ++b)
#pragma unroll
            for (int m = 0; m < 4; ++m)
#pragma unroll
                for (int n = 0; n < 2; ++n) acc[a][b][m][n] = (f32x4){0.f, 0.f, 0.f, 0.f};
    bf16x8 At[4][2], B0[2][2], B1[2][2];
    const char* cA = (const char*)g.A + (size_t)cur.pm * tstep; const char* cB = (const char*)g.Bt + (size_t)cur.pn * tstep;
    S.a_ready(cur);
    if constexpr (SP2) {
        PG8_STAGE(PG8_SB(0, 0), cB, voffB); PG8_STAGE(PG8_SB(0, 1), cB + hstep, voffB); PG8_STAGE(PG8_SA(0, 0), cA, voffA); PG8_STAGE(PG8_SA(0, 1), cA + hstep, voffA);
        if (wr == 1) PG8_BAR;
        PG8_WAIT_V(2); PG8_BAR;
        PG8_STAGE(PG8_SB(1, 0), cB + kstep, voffB); PG8_STAGE(PG8_SA(1, 0), cA + kstep, voffA); PG8_STAGE(PG8_SB(1, 1), cB + hstep + kstep, voffB);
        PG8_WAIT_V(6); PG8_BAR;
    } else {
        PG8_STAGE(PG8_SB(0, 0), cB, voffB); PG8_STAGE(PG8_SA(0, 0), cA, voffA); PG8_STAGE(PG8_SB(0, 1), cB + hstep, voffB); PG8_STAGE(PG8_SA(0, 1), cA + hstep, voffA);
        if (wr == 1) PG8_BAR;
        PG8_WAIT_V(4); PG8_BAR;
        PG8_STAGE(PG8_SB(1, 0), cB + kstep, voffB); PG8_STAGE(PG8_SA(1, 0), cA + kstep, voffA); PG8_STAGE(PG8_SB(1, 1), cB + hstep + kstep, voffB);
        PG8_WAIT_V(6); PG8_BAR;
    }
    for (;;) {
        const bool has_next = S.next(ui + 1, nxt);
        const char* nA = has_next ? (const char*)g.A + (size_t)nxt.pm * tstep : cA; const char* nB = has_next ? (const char*)g.Bt + (size_t)nxt.pn * tstep : cB;
        for (int t = 0; t < nt; t += 2) {
            const bool last = (t == nt - 2);
            const char* a1 = cA + (size_t)(t + 1) * kstep;
            const char* a2 = last ? nA : cA + (size_t)(t + 2) * kstep; const char* b2 = last ? nB : cB + (size_t)(t + 2) * kstep;
            const char* a3 = a2 + kstep; const char* b3 = b2 + kstep;
            if (last && has_next) S.a_ready(nxt);
            if constexpr (SP2) {
            PG8_LDB(B0, 0, 0); PG8_LDB(B1, 0, 1); PG8_SCHED; PG8_LDA(At, 0, 0); PG8_STAGE(PG8_SA(1, 1), a1 + hstep, voffA);
            PG8_WAIT_V(8); PG8_WAIT_L(0); PG8_BAR; PG8_MMA(0, 0, At, B0); PG8_MMA(0, 1, At, B1); PG8_BAR; PG8_SCHED;
            PG8_LDA(At, 0, 1); PG8_STAGE(PG8_SB(0, 0), b2, voffB); PG8_STAGE(PG8_SB(0, 1), b2 + hstep, voffB); PG8_STAGE(PG8_SA(0, 0), a2, voffA);
            PG8_WAIT_V(8); PG8_WAIT_L(0); PG8_BAR; PG8_MMA(1, 0, At, B0); PG8_MMA(1, 1, At, B1); PG8_BAR; PG8_SCHED;
            PG8_LDB(B0, 1, 0); PG8_LDB(B1, 1, 1); PG8_SCHED; PG8_LDA(At, 1, 0); PG8_STAGE(PG8_SA(0, 1), a2 + hstep, voffA);
            PG8_WAIT_V(8); PG8_WAIT_L(0); PG8_BAR; PG8_MMA(0, 0, At, B0); PG8_MMA(0, 1, At, B1); PG8_BAR; PG8_SCHED;
            PG8_LDA(At, 1, 1); PG8_STAGE(PG8_SB(1, 0), b3, voffB); PG8_STAGE(PG8_SB(1, 1), b3 + hstep, voffB); PG8_STAGE(PG8_SA(1, 0), a3, voffA);
            PG8_WAIT_V(8); PG8_WAIT_L(0); PG8_BAR; PG8_MMA(1, 0, At, B0); PG8_MMA(1, 1, At, B1); PG8_BAR; PG8_SCHED;
            } else {
            PG8_LDB(B0, 0, 0); PG8_SCHED; PG8_LDA(At, 0, 0); PG8_STAGE(PG8_SA(1, 1), a1 + hstep, voffA);
            PG8_WAIT_L(8); PG8_BAR; PG8_WAIT_L(0); PG8_MMA(0, 0, At, B0); PG8_BAR; PG8_SCHED;
            PG8_LDB(B1, 0, 1); PG8_STAGE(PG8_SB(0, 0), b2, voffB);
            PG8_BAR; PG8_WAIT_L(0); PG8_MMA(0, 1, At, B1); PG8_BAR;
            PG8_LDA(At, 0, 1); PG8_STAGE(PG8_SA(0, 0), a2, voffA);
            PG8_BAR; PG8_WAIT_L(0); PG8_MMA(1, 0, At, B0); PG8_BAR; PG8_SCHED;
            PG8_STAGE(PG8_SB(0, 1), b2 + hstep, voffB);
            PG8_WAIT_V(6); PG8_BAR; PG8_MMA(1, 1, At, B1); PG8_BAR;
            PG8_LDB(B0, 1, 0); PG8_SCHED; PG8_LDA(At, 1, 0); PG8_STAGE(PG8_SA(0, 1), a2 + hstep, voffA);
            PG8_WAIT_L(8); PG8_BAR; PG8_WAIT_L(0); PG8_MMA(0, 0, At, B0); PG8_BAR; PG8_SCHED;
            PG8_LDB(B1, 1, 1); PG8_STAGE(PG8_SB(1, 0), b3, voffB);
            PG8_BAR; PG8_WAIT_L(0); PG8_MMA(0, 1, At, B1); PG8_BAR;
            PG8_LDA(At, 1, 1); PG8_STAGE(PG8_SA(1, 0), a3, voffA);
            PG8_BAR; PG8_WAIT_L(0); PG8_MMA(1, 0, At, B0); PG8_BAR; PG8_SCHED;
            PG8_STAGE(PG8_SB(1, 1), b3 + hstep, voffB);
            PG8_WAIT_V(6); PG8_BAR; PG8_MMA(1, 1, At, B1); PG8_BAR;
            }
        }
        if constexpr (ALIGN_EPI) { if (wr == 0) PG8_BAR; }
        if constexpr (!Epi::AFTER_DRAIN) { E(acc, cur, wr, wc, fr, fq); S.done(cur); }
        if (!has_next) break;
#pragma unroll
        for (int a = 0; a < 2; ++a)
#pragma unroll
            for (int b = 0; b < 2; ++b)
#pragma unroll
                for (int m = 0; m < 4; ++m)
#pragma unroll
                    for (int n = 0; n < 2; ++n) acc[a][b][m][n] = (f32x4){0.f, 0.f, 0.f, 0.f};
        cur = nxt; cA = nA; cB = nB; ++ui;
        if constexpr (ALIGN_EPI) { if (wr == 1) PG8_BAR; }
    }
    PG8_WAIT_V(0);
    if constexpr (!ALIGN_EPI) { if (wr == 0) PG8_BAR; }
    PG8_BAR;
    if constexpr (Epi::AFTER_DRAIN) { E.fused(acc, cur, wr, wc, fr, fq, lds, wid, lane); S.done(cur); }
#undef PG8_SA
#undef PG8_SB
#undef PG8_STAGE
#undef PG8_LDA
#undef PG8_LDB
#undef PG8_MMA
#undef PG8_WAIT_V
#undef PG8_WAIT_L
#undef PG8_BAR
#undef PG8_SCHED
}
}

#ifndef MK_SINGLE
#define MK_SINGLE 1
#endif
#define LAS __attribute__((address_space(3)))
typedef unsigned short bf16;
typedef short v8s __attribute__((ext_vector_type(8)));
typedef short v4s __attribute__((ext_vector_type(4)));
typedef float v16f __attribute__((ext_vector_type(16)));
typedef float v4f __attribute__((ext_vector_type(4)));
typedef float v2f __attribute__((ext_vector_type(2)));
typedef unsigned v4u __attribute__((ext_vector_type(4)));
typedef unsigned v2u __attribute__((ext_vector_type(2)));
constexpr int BATCH = 2, SEQ = 16384, DM = 1024, MROWS = BATCH * SEQ, FF = 4096, PROJ_W = 3072;
constexpr float RMS_EPS = 1e-6f;
constexpr float LOG2E = 1.4426950408889634f;
constexpr float QSCALE = 0.125f * LOG2E;
constexpr size_t MiB = 1u << 20;
constexpr size_t WS_MOD = 0, WS_TA = 128 * 1024, WS_BAR = 256 * 1024, WS_TB = 1 * MiB;
constexpr size_t WS_WABIN = 6 * MiB, WS_WABOUT = 12 * MiB, WS_WCIN = 14 * MiB, WS_WCOUT = 20 * MiB, WS_WUP = 22 * MiB, WS_WDN = 38 * MiB;
constexpr size_t WS_H = 56 * MiB, WS_PROJ = 120 * MiB, WS_HID = 120 * MiB, WS_YMIX = 120 * MiB, WS_ATT = 376 * MiB, WS_OB = 56 * MiB  , WS_LSE = 104 * MiB, WS_YMLP = 376 * MiB, WS_XB = 440 * MiB  , WS_END = 504 * MiB;
constexpr int LDS_BYTES = 131072 + 8192;
constexpr int NPHASE = 20;

struct Args { const float* in[14]; float* out; unsigned char* ws; int ph_lo, ph_hi; };

__device__ __forceinline__ float wave_sum(float v) {
    v += __int_as_float(__builtin_amdgcn_update_dpp(0, __float_as_int(v), 0xB1, 0xF, 0xF, true));
    v += __int_as_float(__builtin_amdgcn_update_dpp(0, __float_as_int(v), 0x4E, 0xF, 0xF, true));
    v += __int_as_float(__builtin_amdgcn_update_dpp(0, __float_as_int(v), 0x141, 0xF, 0xF, true));
    v += __int_as_float(__builtin_amdgcn_update_dpp(0, __float_as_int(v), 0x140, 0xF, 0xF, true));
    const float r0 = __int_as_float(__builtin_amdgcn_readlane(__float_as_int(v), 0)), r1 = __int_as_float(__builtin_amdgcn_readlane(__float_as_int(v), 16));
    const float r2 = __int_as_float(__builtin_amdgcn_readlane(__float_as_int(v), 32)), r3 = __int_as_float(__builtin_amdgcn_readlane(__float_as_int(v), 48));
    return (r0 + r1) + (r2 + r3);
}
__device__ __forceinline__ unsigned cvtpk(float lo, float hi) { typedef __bf16 bf16x2_t __attribute__((ext_vector_type(2))); v2f v = {lo, hi}; bf16x2_t b = __builtin_convertvector(v, bf16x2_t); return __builtin_bit_cast(unsigned, b); }
__device__ __forceinline__ float bf2f(bf16 v) { return __uint_as_float(((unsigned)v) << 16); }
__device__ __forceinline__ bf16 f2bf(float f) { return (bf16)(cvtpk(f, 0.f) & 0xffffu); }

__device__ __forceinline__ void p0_transpose_item(const float* W, int K, int N, bf16* WT, LAS float* scr, int item, int lane, bool hperm = false) {
    const int nblk = N / 32, kb = item / nblk, nb = item % nblk, k0 = 64 * kb, n0 = 32 * nb;
    float wv_[32];
#pragma unroll
    for (int i = 0; i < 32; ++i) { const int kk = 2 * i + (lane >> 5); wv_[i] = W[(size_t)(k0 + kk) * N + n0 + (lane & 31)]; }
#pragma unroll
    for (int i = 0; i < 32; ++i) { const int kk = 2 * i + (lane >> 5); scr[kk * 33 + (lane & 31)] = wv_[i]; }
    asm volatile("s_waitcnt lgkmcnt(0)" ::: "memory");
    const int c = lane & 7;
#pragma unroll
    for (int j = 0; j < 4; ++j) { const int n = (lane >> 3) + 8 * j; const LAS float* s = scr + (8 * c) * 33 + n;
        v4u o; o.x = cvtpk(s[0 * 33], s[1 * 33]); o.y = cvtpk(s[2 * 33], s[3 * 33]); o.z = cvtpk(s[4 * 33], s[5 * 33]); o.w = cvtpk(s[6 * 33], s[7 * 33]);
        int nd = n0 + n; if (hperm) nd = (nd & ~255) | ((nd & 32) << 2) | ((nd & 192) >> 1) | (nd & 31);
        *(v4u*)(WT + (size_t)nd * K + k0 + 8 * c) = o; }
    asm volatile("s_waitcnt lgkmcnt(0)" ::: "memory");
}
__device__ __forceinline__ v2f sincos_red(float ang) {
    const float n = rintf(ang * 0.15915494309189535f);
    float r = fmaf(-n, 6.2831854820251465f, ang);
    r = fmaf(-n, -1.7484556000744883e-07f, r);
    const float fr = r * 0.15915494309189535f;
    v2f o; o.x = __builtin_amdgcn_cosf(fr); o.y = __builtin_amdgcn_sinf(fr); return o;
}
__device__ __forceinline__ void phase_prologue(const Args& a, LAS unsigned char* lds, int tid, int lane, int wave, int G) {
    LAS float* cond = (LAS float*)lds;
    LAS float* red = (LAS float*)(lds + 8192);
    const float* c = a.in[1];
    for (int i = tid; i < 2048; i += 512) { const float v = c[i]; cond[i] = v / (1.f + __expf(-v)); }
    __syncthreads();
    const float* adaw = a.in[2]; const float* adab = a.in[3]; float* mod = (float*)(a.ws + WS_MOD);
    for (int it = blockIdx.x; it < 384; it += G) {
        const int lj = it / 96, n0 = (it % 96) * 32, kg = tid >> 5, cn = tid & 31;
        const float* W = adaw + (size_t)lj * 1024 * 3072 + n0 + cn;
        float a0 = 0.f, a1 = 0.f;
#pragma unroll 32
        for (int k = kg; k < 1024; k += 16) { const float wv = W[(size_t)k * 3072]; a0 += cond[k] * wv; a1 += cond[1024 + k] * wv; }
        red[(kg * 32 + cn) * 2] = a0; red[(kg * 32 + cn) * 2 + 1] = a1;
        __syncthreads();
        if (tid < 64) { const int cn2 = tid & 31, b = tid >> 5; float s = 0.f;
#pragma unroll
            for (int g = 0; g < 16; ++g) s += red[(g * 32 + cn2) * 2 + b];
            mod[((size_t)lj * 2 + b) * 3072 + n0 + cn2] = s + adab[lj * 3072 + n0 + cn2]; }
        __syncthreads();
    }
    v2f* TA = (v2f*)(a.ws + WS_TA); v2f* TB = (v2f*)(a.ws + WS_TB);
    const int gt = blockIdx.x * 512 + tid, NT_ = G * 512;
    for (int i = gt; i < 256 * 16; i += NT_) { const int pos = i >> 4, f = i & 15; const float inv = exp2f(-(float)(2 * f) * (13.287712379549449f / 32.f)); TA[i] = sincos_red((float)pos * inv); }
    for (int i = gt; i < SEQ * 32; i += NT_) { const int pos = i >> 5, f = i & 31; const float inv = exp2f(-(float)(2 * f) * (13.287712379549449f / 64.f)); TB[i] = sincos_red((float)pos * inv); }
    LAS float* scr = (LAS float*)(lds + wave * 16384);
    const int gw = blockIdx.x * 8 + wave, NGW = G * 8;
    constexpr int I_ABIN = 16 * 96, I_ABOUT = 12 * 32, I_CIN = 16 * 96, I_COUT = 16 * 32, I_UP = 16 * 128, I_DN = 64 * 32;
    constexpr int NITEMS = I_ABIN + I_ABOUT + I_CIN + I_COUT + 2 * I_UP + 2 * I_DN;
    for (int it = gw; it < NITEMS; it += NGW) {
        int r = it;
        if (r < I_ABIN) { p0_transpose_item(a.in[5], 1024, 3072, (bf16*)(a.ws + WS_WABIN), scr, r, lane, true); continue; } r -= I_ABIN;
        if (r < I_ABOUT) { p0_transpose_item(a.in[6], 768, 1024, (bf16*)(a.ws + WS_WABOUT), scr, r, lane); continue; } r -= I_ABOUT;
        if (r < I_CIN) { p0_transpose_item(a.in[9], 1024, 3072, (bf16*)(a.ws + WS_WCIN), scr, r, lane); continue; } r -= I_CIN;
        if (r < I_COUT) { p0_transpose_item(a.in[10], 1024, 1024, (bf16*)(a.ws + WS_WCOUT), scr, r, lane); continue; } r -= I_COUT;
        if (r < 2 * I_UP) { const int l = r / I_UP; p0_transpose_item(a.in[12] + (size_t)l * 1024 * 4096, 1024, 4096, (bf16*)(a.ws + WS_WUP + (size_t)l * 8 * MiB), scr, r % I_UP, lane); continue; } r -= 2 * I_UP;
        { const int l = r / I_DN; p0_transpose_item(a.in[13] + (size_t)l * 4096 * 1024, 4096, 1024, (bf16*)(a.ws + WS_WDN + (size_t)l * 8 * MiB), scr, r % I_DN, lane); }
    }
}

template <bool XIN16, bool XOUT16>
__device__ __forceinline__ void rows_phase(const void* xin_, void* xout_, const bf16* Y, const float* gpost, const float* gmod,
                                           bf16* H, const float* gpre, const float* nmod, int gw, int NGW, int lane) {
    constexpr int R = 4;
    for (int m0 = gw; m0 < MROWS; m0 += R * NGW) {
        v4f x[R][4]; v2u yr[R][4];
#pragma unroll
        for (int r = 0; r < R; ++r) { const size_t m = (size_t)(m0 + r * NGW);
#pragma unroll
            for (int j = 0; j < 4; ++j) {
                if (XIN16) { const v2u xr = ((const v2u*)((const bf16*)xin_ + m * DM))[lane + 64 * j];
                    x[r][j].x = __uint_as_float(xr.x << 16); x[r][j].y = __uint_as_float(xr.x & 0xffff0000u); x[r][j].z = __uint_as_float(xr.y << 16); x[r][j].w = __uint_as_float(xr.y & 0xffff0000u); }
                else x[r][j] = ((const v4f*)((const float*)xin_ + m * DM))[lane + 64 * j];
                if (Y) yr[r][j] = ((const v2u*)(Y + m * DM))[lane + 64 * j]; } }
        int bcur = m0 / SEQ;
        v4f gg[4], gp[4], sh[4];
#define ROWS_PARAMS(b_) do { _Pragma("unroll") for (int j = 0; j < 4; ++j) { const int col = 4 * (lane + 64 * j); \
            if (Y) gg[j] = *(const v4f*)(gmod + (b_) * 3072 + 2048 + col) * *(const v4f*)(gpost + col); \
            if (H) { gp[j] = *(const v4f*)(gpre + col) * (*(const v4f*)(nmod + (b_) * 3072 + 1024 + col) + 1.0f); sh[j] = *(const v4f*)(nmod + (b_) * 3072 + col); } } } while (0)
        ROWS_PARAMS(bcur);
#pragma unroll
        for (int r = 0; r < R; ++r) { const int m = m0 + r * NGW; const int b = m / SEQ;
            if (b != bcur) { bcur = b; ROWS_PARAMS(bcur); }
            if (Y) {
                v4f y[4]; float ss = 0.f;
#pragma unroll
                for (int j = 0; j < 4; ++j) { y[j].x = __uint_as_float(yr[r][j].x << 16); y[j].y = __uint_as_float(yr[r][j].x & 0xffff0000u); y[j].z = __uint_as_float(yr[r][j].y << 16); y[j].w = __uint_as_float(yr[r][j].y & 0xffff0000u);
                    ss += (y[j].x * y[j].x + y[j].y * y[j].y) + (y[j].z * y[j].z + y[j].w * y[j].w); }
                const float rstd = 1.0f / sqrtf(wave_sum(ss) * (1.f / DM) + RMS_EPS);
#pragma unroll
                for (int j = 0; j < 4; ++j) { x[r][j] = x[r][j] + gg[j] * (y[j] * rstd);
                    if (XOUT16) { v2u o; o.x = cvtpk(x[r][j].x, x[r][j].y); o.y = cvtpk(x[r][j].z, x[r][j].w); ((v2u*)((bf16*)xout_ + (size_t)m * DM))[lane + 64 * j] = o; }
                    else ((v4f*)((float*)xout_ + (size_t)m * DM))[lane + 64 * j] = x[r][j]; }
            }
            if (H) {
                float ss = 0.f;
#pragma unroll
                for (int j = 0; j < 4; ++j) ss += (x[r][j].x * x[r][j].x + x[r][j].y * x[r][j].y) + (x[r][j].z * x[r][j].z + x[r][j].w * x[r][j].w);
                const float rstd = 1.0f / sqrtf(wave_sum(ss) * (1.f / DM) + RMS_EPS);
#pragma unroll
                for (int j = 0; j < 4; ++j) { const v4f hv = x[r][j] * rstd * gp[j] + sh[j]; v2u o; o.x = cvtpk(hv.x, hv.y); o.y = cvtpk(hv.z, hv.w);
                    ((v2u*)(H + (size_t)m * DM))[lane + 64 * j] = o; }
            }
        }
#undef ROWS_PARAMS
    }
}

__device__ __forceinline__ void combine_phase(const Args& a, int gw, int NGW, int lane) {
    const bf16* OB = (const bf16*)(a.ws + WS_OB); const float* LSE = (const float*)(a.ws + WS_LSE); bf16* ATT = (bf16*)(a.ws + WS_ATT);
    const int j = lane >> 4;
    constexpr int R = 4;
    for (int m0 = gw; m0 < MROWS; m0 += R * NGW) {
        float l[R][3]; v2u ov[R][3];
#pragma unroll
        for (int r = 0; r < R; ++r) { const size_t m = (size_t)(m0 + r * NGW);
#pragma unroll
            for (int g = 0; g < 3; ++g) { l[r][g] = LSE[(size_t)g * MROWS * 4 + m * 4 + j]; ov[r][g] = *(const v2u*)(OB + (size_t)g * MROWS * 256 + m * 256 + 4 * lane); } }
#pragma unroll
        for (int r = 0; r < R; ++r) { const size_t m = (size_t)(m0 + r * NGW);
            const float mx = fmaxf(l[r][0], fmaxf(l[r][1], l[r][2]));
            float w[3]; float s_ = 0.f;
#pragma unroll
            for (int g = 0; g < 3; ++g) { w[g] = __builtin_amdgcn_exp2f(l[r][g] - mx); s_ += w[g]; }
            const float inv = 1.0f / s_;
            float acc[4] = {0.f, 0.f, 0.f, 0.f};
#pragma unroll
            for (int g = 0; g < 3; ++g) { const float wg = w[g] * inv;
                acc[0] += wg * __uint_as_float(ov[r][g].x << 16); acc[1] += wg * __uint_as_float(ov[r][g].x & 0xffff0000u);
                acc[2] += wg * __uint_as_float(ov[r][g].y << 16); acc[3] += wg * __uint_as_float(ov[r][g].y & 0xffff0000u); }
            v2u o; o.x = cvtpk(acc[0], acc[1]); o.y = cvtpk(acc[2], acc[3]);
            *(v2u*)(ATT + m * 768 + 512 + 4 * lane) = o; }
    }
}

constexpr int ARS = 144, ATILE = 64 * ARS, ABUF = 2 * ATILE;
struct AUnit {
    const bf16* Q; const bf16* K; const bf16* V; int pitch;
    int q_base, q_stride, k_base, k_stride, k_idx0, k_len, nt;
    bf16* O; int o_pitch; float* lse;
    int r0, kr0; const float* rpb;
};
typedef short v4i16_t __attribute__((ext_vector_type(4)));
__device__ __forceinline__ v4s vtr(const LAS unsigned char* p) { return __builtin_bit_cast(v4s, __builtin_amdgcn_ds_read_tr16_b64_v4i16((LAS v4i16_t*)p)); }
__device__ __forceinline__ float half_max(float v) { auto rr = __builtin_amdgcn_permlane32_swap(__float_as_uint(v), __float_as_uint(v), false, false); return fmaxf(__uint_as_float(rr[0]), __uint_as_float(rr[1])); }
__device__ __forceinline__ float half_sum(float v) { auto rr = __builtin_amdgcn_permlane32_swap(__float_as_uint(v), __float_as_uint(v), false, false); return __uint_as_float(rr[0]) + __uint_as_float(rr[1]); }
#define MFMA32(a, b, c) __builtin_amdgcn_mfma_f32_32x32x16_bf16((a), (b), (c), 0, 0, 0)
__device__ __forceinline__ float max3f(float a, float b, float c) { float r; asm("v_max3_f32 %0, %1, %2, %3" : "=v"(r) : "v"(a), "v"(b), "v"(c)); return r; }

__device__ __forceinline__ void store_o_row(bf16* orow, const v16f& o0, const v16f& o1, float inv, int h) {
#pragma unroll
    for (int b = 0; b < 2; ++b)
#pragma unroll
        for (int p = 0; p < 2; ++p) {
            const int ge = 8 * p, go = 8 * p + 4;
            unsigned e0, e1, x0, x1;
            if (b == 0) { e0 = cvtpk(o0[ge] * inv, o0[ge + 1] * inv); e1 = cvtpk(o0[ge + 2] * inv, o0[ge + 3] * inv); x0 = cvtpk(o0[go] * inv, o0[go + 1] * inv); x1 = cvtpk(o0[go + 2] * inv, o0[go + 3] * inv); }
            else        { e0 = cvtpk(o1[ge] * inv, o1[ge + 1] * inv); e1 = cvtpk(o1[ge + 2] * inv, o1[ge + 3] * inv); x0 = cvtpk(o1[go] * inv, o1[go + 1] * inv); x1 = cvtpk(o1[go + 2] * inv, o1[go + 3] * inv); }
            const auto r0 = __builtin_amdgcn_permlane32_swap(e0, x0, false, false);
            const auto r1 = __builtin_amdgcn_permlane32_swap(e1, x1, false, false);
            v4u w; w.x = r0[0]; w.y = r1[0]; w.z = r0[1]; w.w = r1[1];
            *(v4u*)(orow + 32 * b + 16 * p + 8 * h) = w; }
}

template <int MODE>
__device__ __forceinline__ void attn_unit(LAS unsigned char* lds, const AUnit& U) {
    int tid_l = threadIdx.x; asm volatile("" : "+v"(tid_l));
    const int tid = tid_l, lane = tid & 63, w = __builtin_amdgcn_readfirstlane(tid >> 6), q = lane & 31, h = lane >> 5;
    const int sj = tid >> 3, sc = tid & 7;
    const int qi = 32 * w + q;
    const size_t qtok = (size_t)(U.q_base + U.q_stride * qi);
    v8s qr[4];
#pragma unroll
    for (int d0 = 0; d0 < 4; ++d0) qr[d0] = *(const v8s*)(U.Q + qtok * U.pitch + 16 * d0 + 8 * h);
    LAS float* bias = (LAS float*)(lds + 3 * ABUF);
    v4u kst[2], vst[2];
#define GLOAD(t, S_) do { int kidx_ = U.k_idx0 + 64 * (t) + sj; kidx_ = kidx_ < 0 ? 0 : (kidx_ >= U.k_len ? U.k_len - 1 : kidx_); const size_t off_ = (size_t)(U.k_base + U.k_stride * kidx_) * U.pitch + sc * 8; \
        kst[S_] = *(const v4u*)(U.K + off_); vst[S_] = *(const v4u*)(U.V + off_); } while (0)
#define LWRITE(buf, S_) do { *(LAS v4u*)(lds + (buf) * ABUF + sj * ARS + sc * 16) = kst[S_]; *(LAS v4u*)(lds + (buf) * ABUF + ATILE + sj * ARS + sc * 16) = vst[S_]; } while (0)
    GLOAD(0, 0);
    if (U.nt > 1) GLOAD(1, 1);
    __syncthreads();
    if (MODE == 2) { for (int i = tid; i < 465; i += 512) bias[i] = U.rpb[i] * LOG2E; }
    LWRITE(0, 0);
    if (U.nt > 2) GLOAD(2, 0);
    v16f o0, o1;
#pragma unroll
    for (int i = 0; i < 16; ++i) { o0[i] = 0.f; o1[i] = 0.f; }
    float m_run = (MODE == 0) ? 0.f : -1e30f, l_run = 0.f;
    v16f negm;
#pragma unroll
    for (int i = 0; i < 16; ++i) negm[i] = 0.f;
    const int piq = (q & 0x13) | ((q & 4) << 1) | ((q & 8) >> 1);
    const int koff = piq * ARS + 16 * h;
    const int i16 = lane & 15, tq = i16 >> 2, tp = i16 & 3, blk = (lane >> 4) & 1;
    const int voff = (8 * h + tq) * ARS + 32 * blk + 8 * tp;
    const int nr = U.r0 + (w >> 1), nc = 32 * (w & 1) + q;
    const int nrs = nr - 4 < 0 ? 0 : (nr - 4 > 248 ? 248 : nr - 4);
    const int ncs = nc - 8 < 0 ? 0 : (nc - 8 > 48 ? 48 : nc - 8);
    v8s kf0[4], kf1[4];
#define KLOAD(base) do { _Pragma("unroll") for (int d0_ = 0; d0_ < 4; ++d0_) { kf0[d0_] = *(const LAS v8s*)((base) + koff + d0_ * 32); kf1[d0_] = *(const LAS v8s*)((base) + 32 * ARS + koff + d0_ * 32); } } while (0)
    __syncthreads();
    KLOAD(lds);
    if (U.nt > 1) LWRITE(1, 1);
    int bcur = 0;
    for (int t0 = 0; t0 < U.nt; t0 += 2) {
#pragma unroll
      for (int u_ = 0; u_ < 2; ++u_) {
        const int t = t0 + u_;
        if (t < U.nt) {
        __syncthreads();
        if (t + 3 < U.nt) GLOAD(t + 3, u_ ^ 1);
        const int bnext = bcur == 2 ? 0 : bcur + 1, bnn = bnext == 2 ? 0 : bnext + 1;
        const LAS unsigned char* vt = lds + bcur * ABUF + ATILE;
        bool active = true;
        if (MODE == 1) { const int k0t = U.k_idx0 + 64 * t; active = (t >= (w >> 1)) && (t <= (w >> 1) + 2) && (k0t >= 0) && (k0t < U.k_len); }
        if (MODE == 2) { const int kr = U.kr0 + t; active = (kr >= nrs) && (kr < nrs + 8); }
        if (active) {
            v16f p0, p1;
            if (MODE == 0) { p0 = negm; p1 = negm; }
            else {
#pragma unroll
                for (int i = 0; i < 16; ++i) { p0[i] = 0.f; p1[i] = 0.f; } }
#pragma unroll
            for (int d0 = 0; d0 < 4; ++d0) { p0 = MFMA32(kf0[d0], qr[d0], p0); p1 = MFMA32(kf1[d0], qr[d0], p1); }
            if (t + 1 < U.nt) KLOAD(lds + bnext * ABUF);
            if (MODE == 1) {
                const int tau = t - (w >> 1), qq = 32 * (w & 1) + q - 8 * h;
                if (tau == 0) {
#pragma unroll
                    for (int i = 0; i < 16; ++i) { const int jj = 16 * (i >> 3) + (i & 7); p0[i] = (jj >= qq) ? p0[i] : -INFINITY; p1[i] = (jj + 32 >= qq) ? p1[i] : -INFINITY; }
                } else if (tau == 2) {
#pragma unroll
                    for (int i = 0; i < 16; ++i) { const int jj = 16 * (i >> 3) + (i & 7); p0[i] = (jj <= qq) ? p0[i] : -INFINITY; p1[i] = (jj + 32 <= qq) ? p1[i] : -INFINITY; }
                }
            }
            if (MODE == 2) {
                const int kr = U.kr0 + t; const int rowoff = (kr - nr + 7) * 31 + 15 - nc;
#pragma unroll
                for (int i = 0; i < 16; ++i) { const int kc = 8 * h + 16 * (i >> 3) + (i & 7);
                    const bool ok0 = (unsigned)(kc - ncs) < 16u, ok1 = (unsigned)(kc + 32 - ncs) < 16u;
                    const float b0 = bias[ok0 ? rowoff + kc : 0], b1 = bias[ok1 ? rowoff + kc + 32 : 0];
                    p0[i] = ok0 ? fmaf(p0[i], QSCALE, b0) : -INFINITY; p1[i] = ok1 ? fmaf(p1[i], QSCALE, b1) : -INFINITY; }
            }
            if (MODE == 3) {
                float rs = 0.f;
#pragma unroll
                for (int i = 0; i < 16; ++i) { p0[i] = __builtin_amdgcn_exp2f(p0[i]); p1[i] = __builtin_amdgcn_exp2f(p1[i]); rs += p0[i] + p1[i]; }
                l_run += rs;
            } else if (MODE == 0) {
                float ma = max3f(p0[0], p0[1], p1[0]), mb = max3f(p0[2], p0[3], p1[1]); ma = max3f(ma, p1[2], p1[3]);
#pragma unroll
                for (int i = 4; i < 16; i += 4) { ma = max3f(ma, p0[i], p0[i + 1]); mb = max3f(mb, p0[i + 2], p0[i + 3]); ma = max3f(ma, p1[i], p1[i + 1]); mb = max3f(mb, p1[i + 2], p1[i + 3]); }
                const float mx = half_max(fmaxf(ma, mb));
                if (t == 0 || __any(mx > 8.0f)) {
                    const float dl = (t == 0) ? mx : fmaxf(mx, 0.f);
                    const float alpha = (t == 0) ? 1.0f : __builtin_amdgcn_exp2f(-dl);
                    m_run += dl;
#pragma unroll
                    for (int i = 0; i < 16; ++i) { p0[i] -= dl; p1[i] -= dl; o0[i] *= alpha; o1[i] *= alpha; negm[i] = -m_run; }
                    l_run *= alpha;
                }
                float rs = 0.f;
#pragma unroll
                for (int i = 0; i < 16; ++i) { p0[i] = __builtin_amdgcn_exp2f(p0[i]); p1[i] = __builtin_amdgcn_exp2f(p1[i]); rs += p0[i] + p1[i]; }
                l_run += rs;
            } else {
            float mx = fmaxf(p0[0], p1[0]);
#pragma unroll
            for (int i = 1; i < 16; ++i) mx = fmaxf(mx, fmaxf(p0[i], p1[i]));
            mx = half_max(mx);
            const float m_new = fmaxf(m_run, mx);
            const float alpha = __builtin_amdgcn_exp2f(m_run - m_new);
            m_run = m_new;
            float rs = 0.f;
#pragma unroll
            for (int i = 0; i < 16; ++i) { p0[i] = __builtin_amdgcn_exp2f(p0[i] - m_new); p1[i] = __builtin_amdgcn_exp2f(p1[i] - m_new); rs += p0[i] + p1[i]; }
            l_run = l_run * alpha + rs;
            if (__any(alpha != 1.0f)) {
#pragma unroll
                for (int i = 0; i < 16; ++i) { o0[i] *= alpha; o1[i] *= alpha; }
            }
            }
#pragma unroll
            for (int kb = 0; kb < 2; ++kb)
#pragma unroll
                for (int s = 0; s < 2; ++s) {
                    v4u pw;
                    if (kb == 0) { pw.x = cvtpk(p0[8 * s], p0[8 * s + 1]); pw.y = cvtpk(p0[8 * s + 2], p0[8 * s + 3]); pw.z = cvtpk(p0[8 * s + 4], p0[8 * s + 5]); pw.w = cvtpk(p0[8 * s + 6], p0[8 * s + 7]); }
                    else         { pw.x = cvtpk(p1[8 * s], p1[8 * s + 1]); pw.y = cvtpk(p1[8 * s + 2], p1[8 * s + 3]); pw.z = cvtpk(p1[8 * s + 4], p1[8 * s + 5]); pw.w = cvtpk(p1[8 * s + 6], p1[8 * s + 7]); }
                    const v8s pf = __builtin_bit_cast(v8s, pw);
                    const LAS unsigned char* vp = vt + (32 * kb + 16 * s) * ARS + voff;
                    const v4s lo0 = vtr(vp), hi0 = vtr(vp + 4 * ARS), lo1 = vtr(vp + 64), hi1 = vtr(vp + 4 * ARS + 64);
                    const v8s vf0 = __builtin_shufflevector(lo0, hi0, 0, 1, 2, 3, 4, 5, 6, 7), vf1 = __builtin_shufflevector(lo1, hi1, 0, 1, 2, 3, 4, 5, 6, 7);
                    o0 = MFMA32(vf0, pf, o0); o1 = MFMA32(vf1, pf, o1);
                }
        }
        else if (t + 1 < U.nt) KLOAD(lds + bnext * ABUF);
        if (t + 2 < U.nt) LWRITE(bnn, u_);
        bcur = bnext;
        }
      }
    }
#undef GLOAD
#undef LWRITE
#undef KLOAD
    l_run = half_sum(l_run);
    const float inv = 1.0f / l_run;
    bf16* orow = U.O + qtok * U.o_pitch;
    store_o_row(orow, o0, o1, inv, h);
    if (MODE == 1) { if (h == 0) U.lse[qtok * 4] = m_run + __log2f(l_run); }
}

__device__ __forceinline__ void attn_unit_dense64(LAS unsigned char* lds, const AUnit& U) {
    int tid_l = threadIdx.x; asm volatile("" : "+v"(tid_l));
    const int tid = tid_l, lane = tid & 63, w = __builtin_amdgcn_readfirstlane(tid >> 6), q = lane & 31, h = lane >> 5;
    const int sj = tid >> 3, sc = tid & 7;
    const size_t qtokA = (size_t)(U.q_base + 64 * w + q), qtokB = qtokA + 32;
    v8s qa[4], qb[4];
#pragma unroll
    for (int d0 = 0; d0 < 4; ++d0) { qa[d0] = *(const v8s*)(U.Q + qtokA * U.pitch + 16 * d0 + 8 * h); qb[d0] = *(const v8s*)(U.Q + qtokB * U.pitch + 16 * d0 + 8 * h); }
    v4u kreg, vreg;
    const bf16* kg = U.K + (size_t)sj * U.pitch + sc * 8; const bf16* vg = U.V + (size_t)sj * U.pitch + sc * 8;
    const size_t tstride = (size_t)64 * U.pitch;
#define GLOADP(t) do { kreg = *(const v4u*)(kg + (size_t)(t) * tstride); vreg = *(const v4u*)(vg + (size_t)(t) * tstride); } while (0)
#define LWRITEP(buf) do { *(LAS v4u*)(lds + (buf) * ABUF + sj * ARS + sc * 16) = kreg; *(LAS v4u*)(lds + (buf) * ABUF + ATILE + sj * ARS + sc * 16) = vreg; } while (0)
    const int piq = (q & 0x13) | ((q & 4) << 1) | ((q & 8) >> 1);
    const int koff = piq * ARS + 16 * h;
    const int i16 = lane & 15, tq = i16 >> 2, tp = i16 & 3, blk = (lane >> 4) & 1;
    const int voff = (8 * h + tq) * ARS + 32 * blk + 8 * tp;
    GLOADP(0);
    __syncthreads();
    LWRITEP(0); GLOADP(1); LWRITEP(1);
    v16f oa0, oa1, ob0, ob1;
#pragma unroll
    for (int i = 0; i < 16; ++i) { oa0[i] = 0.f; oa1[i] = 0.f; ob0[i] = 0.f; ob1[i] = 0.f; }
    float la = 0.f, lb = 0.f;
    int bcur = 0;
    for (int t = 0; t < U.nt; ++t) {
        __syncthreads();
        if (t + 2 < U.nt) GLOADP(t + 2);
        const int bnext = bcur == 2 ? 0 : bcur + 1, bnn = bnext == 2 ? 0 : bnext + 1;
        const LAS unsigned char* kt = lds + bcur * ABUF + koff; const LAS unsigned char* vt = lds + bcur * ABUF + ATILE + voff;
        v16f pa0, pa1, pb0, pb1;
#pragma unroll
        for (int i = 0; i < 16; ++i) { pa0[i] = 0.f; pa1[i] = 0.f; pb0[i] = 0.f; pb1[i] = 0.f; }
#pragma unroll
        for (int d0 = 0; d0 < 4; ++d0) {
            const v8s k0 = *(const LAS v8s*)(kt + d0 * 32), k1 = *(const LAS v8s*)(kt + 32 * ARS + d0 * 32);
            pa0 = MFMA32(k0, qa[d0], pa0); pa1 = MFMA32(k1, qa[d0], pa1); pb0 = MFMA32(k0, qb[d0], pb0); pb1 = MFMA32(k1, qb[d0], pb1);
        }
        float ra = 0.f, rb = 0.f;
#pragma unroll
        for (int i = 0; i < 16; ++i) { pa0[i] = __builtin_amdgcn_exp2f(pa0[i]); pa1[i] = __builtin_amdgcn_exp2f(pa1[i]); ra += pa0[i] + pa1[i];
                                       pb0[i] = __builtin_amdgcn_exp2f(pb0[i]); pb1[i] = __builtin_amdgcn_exp2f(pb1[i]); rb += pb0[i] + pb1[i]; }
        la += ra; lb += rb;
#pragma unroll
        for (int kb = 0; kb < 2; ++kb)
#pragma unroll
            for (int s_ = 0; s_ < 2; ++s_) {
                v4u wa, wb;
                if (kb == 0) { wa.x = cvtpk(pa0[8 * s_], pa0[8 * s_ + 1]); wa.y = cvtpk(pa0[8 * s_ + 2], pa0[8 * s_ + 3]); wa.z = cvtpk(pa0[8 * s_ + 4], pa0[8 * s_ + 5]); wa.w = cvtpk(pa0[8 * s_ + 6], pa0[8 * s_ + 7]);
                               wb.x = cvtpk(pb0[8 * s_], pb0[8 * s_ + 1]); wb.y = cvtpk(pb0[8 * s_ + 2], pb0[8 * s_ + 3]); wb.z = cvtpk(pb0[8 * s_ + 4], pb0[8 * s_ + 5]); wb.w = cvtpk(pb0[8 * s_ + 6], pb0[8 * s_ + 7]); }
                else         { wa.x = cvtpk(pa1[8 * s_], pa1[8 * s_ + 1]); wa.y = cvtpk(pa1[8 * s_ + 2], pa1[8 * s_ + 3]); wa.z = cvtpk(pa1[8 * s_ + 4], pa1[8 * s_ + 5]); wa.w = cvtpk(pa1[8 * s_ + 6], pa1[8 * s_ + 7]);
                               wb.x = cvtpk(pb1[8 * s_], pb1[8 * s_ + 1]); wb.y = cvtpk(pb1[8 * s_ + 2], pb1[8 * s_ + 3]); wb.z = cvtpk(pb1[8 * s_ + 4], pb1[8 * s_ + 5]); wb.w = cvtpk(pb1[8 * s_ + 6], pb1[8 * s_ + 7]); }
                const v8s pfa = __builtin_bit_cast(v8s, wa), pfb = __builtin_bit_cast(v8s, wb);
                const LAS unsigned char* vp = vt + (32 * kb + 16 * s_) * ARS;
                const v4s lo0 = vtr(vp), hi0 = vtr(vp + 4 * ARS), lo1 = vtr(vp + 64), hi1 = vtr(vp + 4 * ARS + 64);
                const v8s vf0 = __builtin_shufflevector(lo0, hi0, 0, 1, 2, 3, 4, 5, 6, 7), vf1 = __builtin_shufflevector(lo1, hi1, 0, 1, 2, 3, 4, 5, 6, 7);
                oa0 = MFMA32(vf0, pfa, oa0); oa1 = MFMA32(vf1, pfa, oa1); ob0 = MFMA32(vf0, pfb, ob0); ob1 = MFMA32(vf1, pfb, ob1);
            }
        if (t + 2 < U.nt) LWRITEP(bnn);
        bcur = bnext;
    }
#undef GLOADP
#undef LWRITEP
    la = half_sum(la); lb = half_sum(lb);
    const float ia = 1.0f / la, ib = 1.0f / lb;
    bf16* orA = U.O + qtokA * U.o_pitch; bf16* orB = U.O + qtokB * U.o_pitch;
    store_o_row(orA, oa0, oa1, ia, h); store_o_row(orB, ob0, ob1, ib, h);
}

__device__ __forceinline__ void attn_unit_na(LAS unsigned char* lds, const AUnit& U) {
    int tid_l = threadIdx.x; asm volatile("" : "+v"(tid_l));
    const int tid = tid_l, lane = tid & 63, w = __builtin_amdgcn_readfirstlane(tid >> 6), q = lane & 31, h = lane >> 5;
    const int sj = tid >> 3, sc = tid & 7;
    const int rp = w >> 2, cg = w & 3;
    const int ra = U.r0 + 2 * rp, nr = ra + (q >> 4), nc = 16 * cg + (q & 15);
    const int kc0 = cg == 0 ? 0 : (cg == 1 ? 8 : (cg == 2 ? 24 : 32));
    const size_t qtok = (size_t)(nr * 64 + nc);
    v8s qr[4];
#pragma unroll
    for (int d0 = 0; d0 < 4; ++d0) qr[d0] = *(const v8s*)(U.Q + qtok * U.pitch + 16 * d0 + 8 * h);
    LAS float* bias = (LAS float*)(lds + 3 * ABUF) + 64;
    v4u kst[2], vst[2];
    const bf16* kg = U.K + (size_t)(U.k_base + sj) * U.pitch + sc * 8; const bf16* vg = U.V + (size_t)(U.k_base + sj) * U.pitch + sc * 8;
    const size_t tstride = (size_t)64 * U.pitch;
#define GLOADP(t, S_) do { kst[S_] = *(const v4u*)(kg + (size_t)(t) * tstride); vst[S_] = *(const v4u*)(vg + (size_t)(t) * tstride); } while (0)
#define LWRITEP(buf, S_) do { *(LAS v4u*)(lds + (buf) * ABUF + sj * ARS + sc * 16) = kst[S_]; *(LAS v4u*)(lds + (buf) * ABUF + ATILE + sj * ARS + sc * 16) = vst[S_]; } while (0)
    const int piq = (q & 0x13) | ((q & 4) << 1) | ((q & 8) >> 1);
    const int koff = (kc0 + piq) * ARS + 16 * h;
    const int i16 = lane & 15, tq = i16 >> 2, tp = i16 & 3, blk = (lane >> 4) & 1;
    const int voff = (kc0 + 8 * h + tq) * ARS + 32 * blk + 8 * tp;
    const int nrs = nr - 4 < 0 ? 0 : (nr - 4 > 248 ? 248 : nr - 4);
    const int ncs = nc - 8 < 0 ? 0 : (nc - 8 > 48 ? 48 : nc - 8);
    const int wlo = ra - 4 < 0 ? 0 : (ra - 4 > 248 ? 248 : ra - 4), whi = (ra - 3 < 0 ? 0 : (ra - 3 > 248 ? 248 : ra - 3)) + 8;
    GLOADP(0, 0);
    if (U.nt > 1) GLOADP(1, 1);
    __syncthreads();
    for (int i = tid; i < 465 + 128 + 64; i += 512) { const int k = i - 64; bias[k] = (k >= 0 && k < 465) ? U.rpb[k] * LOG2E : (k >= 465 + 64 ? -INFINITY : 0.f); }
    LWRITEP(0, 0);
    if (U.nt > 2) GLOADP(2, 0);
    if (U.nt > 1) LWRITEP(1, 1);
    v16f o0, o1, pen;
#pragma unroll
    for (int i = 0; i < 16; ++i) { o0[i] = 0.f; o1[i] = 0.f; const int kc = kc0 + 8 * h + 16 * (i >> 3) + (i & 7); pen[i] = ((unsigned)(kc - ncs) < 16u) ? 0.f : -INFINITY; }
    const int bbase = 15 - nc + kc0 + 8 * h;
    float m_run = 0.f, l_run = 0.f; bool started = false;
    v16f penm;
#pragma unroll
    for (int i = 0; i < 16; ++i) penm[i] = pen[i];
    int bcur = 0;
    for (int t0 = 0; t0 < U.nt; t0 += 2) {
#pragma unroll
      for (int u_ = 0; u_ < 2; ++u_) {
        const int t = t0 + u_;
        if (t < U.nt) {
        __syncthreads();
        if (t + 3 < U.nt) GLOADP(t + 3, u_ ^ 1);
        const int bnext = bcur == 2 ? 0 : bcur + 1, bnn = bnext == 2 ? 0 : bnext + 1;
        const int kr = U.kr0 + t;
        if (kr >= wlo && kr < whi) {
            const LAS unsigned char* kt = lds + bcur * ABUF + koff; const LAS unsigned char* vt = lds + bcur * ABUF + ATILE + voff;
            v16f p = penm;
#pragma unroll
            for (int d0 = 0; d0 < 4; ++d0) { const v8s k0 = *(const LAS v8s*)(kt + d0 * 32); p = MFMA32(k0, qr[d0], p); }
            const bool rowok = (kr >= nrs) && (kr < nrs + 8);
            int dr = kr - nr + 7; dr = dr < 0 ? 0 : (dr > 14 ? 14 : dr);
            const LAS float* brow = rowok ? bias + dr * 31 + bbase : bias + 465 + 64;
#pragma unroll
            for (int i = 0; i < 16; ++i) p[i] = fmaf(p[i], QSCALE, brow[16 * (i >> 3) + (i & 7)]);
            float ma = max3f(p[0], p[1], p[2]), mb = max3f(p[3], p[4], p[5]);
            ma = max3f(ma, p[6], p[7]); mb = max3f(mb, p[8], p[9]); ma = max3f(ma, p[10], p[11]); mb = max3f(mb, p[12], p[13]); ma = max3f(ma, p[14], p[15]);
            const float mx = half_max(fmaxf(ma, mb));
            const bool need = started ? (mx > 8.0f) : (mx > -INFINITY);
            if (__any(need)) {
                const float dl = need ? (started ? fmaxf(mx, 0.f) : mx) : 0.f;
                const float alpha = (need && started) ? __builtin_amdgcn_exp2f(-dl) : 1.0f;
                m_run += dl; started = started || need;
#pragma unroll
                for (int i = 0; i < 16; ++i) { p[i] -= dl; o0[i] *= alpha; o1[i] *= alpha; penm[i] = (pen[i] - m_run) * (1.0f / QSCALE); }
                l_run *= alpha;
            }
            float rs = 0.f;
#pragma unroll
            for (int i = 0; i < 16; ++i) { p[i] = __builtin_amdgcn_exp2f(p[i]); rs += p[i]; }
            l_run += rs;
#pragma unroll
            for (int s_ = 0; s_ < 2; ++s_) {
                v4u pw; pw.x = cvtpk(p[8 * s_], p[8 * s_ + 1]); pw.y = cvtpk(p[8 * s_ + 2], p[8 * s_ + 3]); pw.z = cvtpk(p[8 * s_ + 4], p[8 * s_ + 5]); pw.w = cvtpk(p[8 * s_ + 6], p[8 * s_ + 7]);
                const v8s pf = __builtin_bit_cast(v8s, pw);
                const LAS unsigned char* vp = vt + (16 * s_) * ARS;
                const v4s lo0 = vtr(vp), hi0 = vtr(vp + 4 * ARS), lo1 = vtr(vp + 64), hi1 = vtr(vp + 4 * ARS + 64);
                const v8s vf0 = __builtin_shufflevector(lo0, hi0, 0, 1, 2, 3, 4, 5, 6, 7), vf1 = __builtin_shufflevector(lo1, hi1, 0, 1, 2, 3, 4, 5, 6, 7);
                o0 = MFMA32(vf0, pf, o0); o1 = MFMA32(vf1, pf, o1);
            }
        }
        if (t + 2 < U.nt) LWRITEP(bnn, u_);
        bcur = bnext;
        }
      }
    }
#undef GLOADP
#undef LWRITEP
    l_run = half_sum(l_run);
    const float inv = 1.0f / l_run;
    bf16* orow = U.O + qtok * U.o_pitch;
    store_o_row(orow, o0, o1, inv, h);
}

__device__ __forceinline__ void attn_phase_l0(const Args& a, LAS unsigned char* lds, int vcu, int G) {
    const bf16* PROJ = (const bf16*)(a.ws + WS_PROJ); bf16* ATT = (bf16*)(a.ws + WS_ATT);
    bool fixedref;
    { const int ln = threadIdx.x & 63; float gq = fabsf(a.in[7][ln]), gk = fabsf(a.in[8][ln]);
#pragma unroll
      for (int o = 1; o < 64; o <<= 1) { gq = fmaxf(gq, __shfl_xor(gq, o)); gk = fmaxf(gk, __shfl_xor(gk, o)); }
      const float bound = 64.f * gq * gk * QSCALE * 1.02f;
      fixedref = __builtin_amdgcn_readfirstlane(bound < 60.f ? 1 : 0) != 0; }
    { bf16* OB = (bf16*)(a.ws + WS_OB); float* LSE = (float*)(a.ws + WS_LSE);
      const int per = (1536 + G - 1) / G;
      for (int i = 0; i < per; ++i) { const int u = vcu * per + i; if (u >= 1536) break;
        const int uu = u & 63, bgj = u >> 6, j = bgj & 3, g = (bgj >> 2) % 3, b = bgj / 12;
        const int d = g == 0 ? 1 : (g == 1 ? 4 : 16), L = SEQ / d, nb = L / 256, r = uu / nb, i0 = (uu % nb) * 256;
        const bf16* base = PROJ + (size_t)b * SEQ * PROJ_W;
        AUnit U; U.Q = base + 768 + g * 256 + j * 64; U.K = base + 1536 + g * 256 + j * 64; U.V = base + 2304 + g * 256 + j * 64; U.pitch = PROJ_W;
        U.q_base = r + d * i0; U.q_stride = d; U.k_base = r; U.k_stride = d; U.k_idx0 = i0 - 64; U.k_len = L; U.nt = 6;
        U.O = OB + (size_t)g * MROWS * 256 + (size_t)b * SEQ * 256 + j * 64; U.o_pitch = 256; U.lse = LSE + (size_t)g * MROWS * 4 + (size_t)b * SEQ * 4 + j; U.r0 = 0; U.kr0 = 0; U.rpb = nullptr;
        attn_unit<1>(lds, U); } }
    if (fixedref) {
      const int per = (512 + G - 1) / G;
      for (int i = 0; i < per; ++i) { const int u = vcu * per + i; if (u >= 512) break;
        const int bh = u >> 5, qb = u & 31, b = bh >> 3, hq = bh & 7, kvh = hq >> 2;
        const bf16* base = PROJ + (size_t)b * SEQ * PROJ_W;
        AUnit U; U.Q = base + hq * 64; U.K = base + 512 + kvh * 64; U.V = base + 640 + kvh * 64; U.pitch = PROJ_W;
        U.q_base = 512 * qb; U.q_stride = 1; U.k_base = 0; U.k_stride = 1; U.k_idx0 = 0; U.k_len = SEQ; U.nt = SEQ / 64;
        U.O = ATT + (size_t)b * SEQ * 768 + hq * 64; U.o_pitch = 768; U.lse = nullptr; U.r0 = 0; U.kr0 = 0; U.rpb = nullptr;
        attn_unit_dense64(lds, U); }
    } else {
      const int per = (1024 + G - 1) / G;
      for (int i = 0; i < per; ++i) { const int u = vcu * per + i; if (u >= 1024) break;
        const int bh = u >> 6, qb = u & 63, b = bh >> 3, hq = bh & 7, kvh = hq >> 2;
        const bf16* base = PROJ + (size_t)b * SEQ * PROJ_W;
        AUnit U; U.Q = base + hq * 64; U.K = base + 512 + kvh * 64; U.V = base + 640 + kvh * 64; U.pitch = PROJ_W;
        U.q_base = 256 * qb; U.q_stride = 1; U.k_base = 0; U.k_stride = 1; U.k_idx0 = 0; U.k_len = SEQ; U.nt = SEQ / 64;
        U.O = ATT + (size_t)b * SEQ * 768 + hq * 64; U.o_pitch = 768; U.lse = nullptr; U.r0 = 0; U.kr0 = 0; U.rpb = nullptr;
        attn_unit<0>(lds, U); } }
}
__device__ __forceinline__ void attn_phase_l1(const Args& a, LAS unsigned char* lds, int vcu, int G) {
    const bf16* PROJ = (const bf16*)(a.ws + WS_PROJ); bf16* ATT = (bf16*)(a.ws + WS_ATT);
    const int per = (2048 + G - 1) / G;
    for (int i = 0; i < per; ++i) { const int u = vcu * per + i; if (u >= 2048) break;
        const int bh = u >> 6, rb = u & 63, b = bh >> 4, hd = bh & 15;
        const bf16* base = PROJ + (size_t)b * SEQ * PROJ_W;
        AUnit U; U.Q = base + hd * 64; U.K = base + 1024 + hd * 64; U.V = base + 2048 + hd * 64; U.pitch = PROJ_W;
        const int r0 = 4 * rb, kr0 = r0 - 4 < 0 ? 0 : (r0 - 4 > 248 ? 248 : r0 - 4), rl = r0 - 1 > 248 ? 248 : r0 - 1;
        U.q_base = 256 * rb; U.q_stride = 1; U.k_base = 64 * kr0; U.k_stride = 1; U.k_idx0 = 0; U.k_len = SEQ; U.nt = (rl < 0 ? 0 : rl) + 8 - kr0;
        U.O = ATT + (size_t)b * SEQ * 1024 + hd * 64; U.o_pitch = 1024; U.lse = nullptr; U.r0 = r0; U.kr0 = kr0; U.rpb = a.in[11] + hd * 465;
        attn_unit_na(lds, U); }
}

#define XB_TMO      128
#define XB_XCNT(j)  (256  + 64 * (j))
#define XB_XSUB(j)  (1280 + 64 * (j))
#define XB_XGEN(j)  (2304 + 64 * (j))
#define XB_TOP      3328
#define XB_TOPGEN   3392
#define XCD_BAR_WORDS 3456
#define XB_SPIN_CAP (1u << 22)

__device__ __forceinline__ unsigned xb_ld(unsigned* p)              { return __hip_atomic_load(p, __ATOMIC_RELAXED, __HIP_MEMORY_SCOPE_AGENT); }
__device__ __forceinline__ unsigned xb_add(unsigned* p, unsigned v) { return __hip_atomic_fetch_add(p, v, __ATOMIC_RELAXED, __HIP_MEMORY_SCOPE_AGENT); }
__device__ __forceinline__ unsigned xb_xcc_id() { return (unsigned)__builtin_amdgcn_s_getreg((3 << 11) | 20) & 0xFu; }
#define XB_SPIN(cond, bar) do { unsigned _sp = 0; while (cond) { __builtin_amdgcn_s_sleep(1); \
    if ((++_sp & 255u) == 0u) { if (xb_ld(&(bar)[XB_TMO])) break; if (_sp > XB_SPIN_CAP) { atomicAdd(&(bar)[XB_TMO], 1u); break; } } } } while (0)

struct XcdBarrier {
    unsigned* bar; unsigned x;
    volatile LAS unsigned* st;
};

__device__ __forceinline__ XcdBarrier xcd_barrier_post(unsigned* bar, volatile LAS unsigned* st) {
    XcdBarrier b; b.bar = bar; b.x = xb_xcc_id(); b.st = st;
    if (threadIdx.x == 0) (void)xb_add(&bar[XB_XCNT(b.x)], 1u);
    return b;
}
__device__ __forceinline__ void xcd_barrier_complete(unsigned* bar, unsigned x, unsigned& nloc, unsigned& nx) {
    const unsigned G = gridDim.x * gridDim.y * gridDim.z;
    unsigned sum, cnt, mine, sp = 0u;
    for (;;) {
        sum = 0u; cnt = 0u; mine = 0u;
#pragma unroll
        for (unsigned j = 0; j < 16; ++j) { const unsigned c = xb_ld(&bar[XB_XCNT(j)]); sum += c; cnt += (c > 0u) ? 1u : 0u; mine = (j == x) ? c : mine; }
        if (sum == G) break;
        __builtin_amdgcn_s_sleep(1);
        if ((++sp & 255u) == 0u) { if (xb_ld(&bar[XB_TMO])) break; if (sp > XB_SPIN_CAP) { atomicAdd(&bar[XB_TMO], 1u); break; } }
    }
    nloc = mine > 0u ? mine : 1u; nx = cnt > 0u ? cnt : 1u;
}

__device__ __forceinline__ void xcd_barrier(const XcdBarrier& b) {
    asm volatile("s_waitcnt vmcnt(0)" ::: "memory");
    __syncthreads();
    if (threadIdx.x == 0) {
        unsigned* bar = b.bar;
        __builtin_amdgcn_s_waitcnt(0);
        unsigned nloc = b.st[0], nx = b.st[1];
        if (nloc == 0u) { xcd_barrier_complete(bar, b.x, nloc, nx); b.st[0] = nloc; b.st[1] = nx; }
        const unsigned old = xb_add(&bar[XB_XSUB(b.x)], 1u);
        const unsigned gen = old / nloc;
        if (old + 1u == (gen + 1u) * nloc) {
            __builtin_amdgcn_fence(__ATOMIC_RELEASE, "agent");
            asm volatile("s_waitcnt vmcnt(0)" ::: "memory");
            const unsigned og = xb_add(&bar[XB_TOP], 1u);
            const unsigned tg = og / nx;
            if (og + 1u == (tg + 1u) * nx) xb_add(&bar[XB_TOPGEN], 1u);
            else XB_SPIN(xb_ld(&bar[XB_TOPGEN]) == tg, bar);
            __builtin_amdgcn_fence(__ATOMIC_ACQUIRE, "agent");
            xb_add(&bar[XB_XGEN(b.x)], 1u);
            asm volatile("s_waitcnt vmcnt(0)" ::: "memory");
        } else {
            XB_SPIN(xb_ld(&bar[XB_XGEN(b.x)]) == gen, bar);
            __builtin_amdgcn_fence(__ATOMIC_ACQUIRE, "agent");
            asm volatile("s_waitcnt vmcnt(0)" ::: "memory");
        }
    }
    __syncthreads();
}

__host__ __device__ __forceinline__ bool phase_empty(int ph) { return ph == 2 + 1 || ph == 2 + 9 + 1 || ph == 2 + 9 + 3; }
template <int PH>
__device__ __forceinline__ void run_phase(const Args& a, LAS unsigned char* lds) {
    const int tid = threadIdx.x, lane = tid & 63, wave = __builtin_amdgcn_readfirstlane(tid >> 6);
    const int G = gridDim.x, bx = blockIdx.x;
    const int vcu = (G % 8 == 0) ? (bx % 8) * (G / 8) + bx / 8 : bx;
    const int gw = bx * 8 + wave, NGW = G * 8;
    float* mod = (float*)(a.ws + WS_MOD); const float* normg = a.in[4];
    bf16* H = (bf16*)(a.ws + WS_H); bf16* PROJ = (bf16*)(a.ws + WS_PROJ); bf16* ATT = (bf16*)(a.ws + WS_ATT); bf16* HID = (bf16*)(a.ws + WS_HID);
    bf16* YMIX = (bf16*)(a.ws + WS_YMIX); bf16* YMLP = (bf16*)(a.ws + WS_YMLP);
    if constexpr (PH == 0) phase_prologue(a, lds, tid, lane, wave, G);
    else if constexpr (PH == 1) rows_phase<false, false>(a.in[0], nullptr, nullptr, nullptr, nullptr, H, normg, mod, gw, NGW, lane);
    else {
        constexpr int l = (PH - 2) / 9, s = (PH - 2) % 9;
        if constexpr (s == 0) {
            pg8::Gemm g{H, (const bf16*)(a.ws + (l == 0 ? WS_WABIN : WS_WCIN)), MROWS, PROJ_W, DM}; pg8::StaticOrder S; S.init(MROWS, PROJ_W, G, bx);
            if constexpr (l == 0) {
                pg8::EpiPrep E{PROJ, PROJ_W, a.in[7], a.in[8], (const pg8::f32x4*)(a.ws + WS_TA), (const pg8::f32x4*)(a.ws + WS_TB), SEQ, QSCALE, RMS_EPS};
                pg8::gemm_phase<pg8::EpiPrep, pg8::StaticOrder, true, true>(lds, g, S, E);
            } else {
                pg8::EpiBf16<0> E{PROJ, PROJ_W};
                pg8::gemm_phase<pg8::EpiBf16<0>, pg8::StaticOrder, true, true>(lds, g, S, E);
            }
        } else if constexpr (s == 1) { }
        else if constexpr (s == 2) { if constexpr (l == 0) attn_phase_l0(a, lds, vcu, G); else attn_phase_l1(a, lds, vcu, G); }
        else if constexpr (s == 3) { if (l == 0) combine_phase(a, gw, NGW, lane); }
        else if constexpr (s == 4) {
            pg8::Gemm g{ATT, (const bf16*)(a.ws + (l == 0 ? WS_WABOUT : WS_WCOUT)), MROWS, DM, l == 0 ? 768 : 1024}; pg8::StaticOrder S; S.init(MROWS, DM, G, bx);
            pg8::EpiBf16<0> E{YMIX, DM};
            pg8::gemm_phase<pg8::EpiBf16<0>, pg8::StaticOrder, true, true>(lds, g, S, E);
        } else if constexpr (s == 5) {
            bf16* XB = (bf16*)(a.ws + WS_XB);
            if constexpr (l == 0) rows_phase<false, true>(a.in[0], XB, YMIX, normg + (l * 4 + 1) * DM, mod + (size_t)(l * 2 + 0) * 2 * 3072, H, normg + (l * 4 + 2) * DM, mod + (size_t)(l * 2 + 1) * 2 * 3072, gw, NGW, lane);
            else rows_phase<true, true>(XB, XB, YMIX, normg + (l * 4 + 1) * DM, mod + (size_t)(l * 2 + 0) * 2 * 3072, H, normg + (l * 4 + 2) * DM, mod + (size_t)(l * 2 + 1) * 2 * 3072, gw, NGW, lane);
        } else if constexpr (s == 6) {
            pg8::Gemm g{H, (const bf16*)(a.ws + WS_WUP + (size_t)l * 8 * MiB), MROWS, FF, DM}; pg8::StaticOrder S; S.init(MROWS, FF, G, bx);
            pg8::EpiBf16<2> E{HID, FF};
            pg8::gemm_phase<pg8::EpiBf16<2>, pg8::StaticOrder, true, true>(lds, g, S, E);
        } else if constexpr (s == 7) {
            pg8::Gemm g{HID, (const bf16*)(a.ws + WS_WDN + (size_t)l * 8 * MiB), MROWS, DM, FF}; pg8::StaticOrder S; S.init(MROWS, DM, G, bx);
            pg8::EpiBf16<0> E{YMLP, DM};
            pg8::gemm_phase<pg8::EpiBf16<0>, pg8::StaticOrder, true, true>(lds, g, S, E);
        } else {
            constexpr bool last = (l == 1);
            bf16* XB = (bf16*)(a.ws + WS_XB);
            if constexpr (last) rows_phase<true, false>(XB, a.out, YMLP, normg + (l * 4 + 3) * DM, mod + (size_t)(l * 2 + 1) * 2 * 3072, nullptr, normg, mod, gw, NGW, lane);
            else rows_phase<true, true>(XB, XB, YMLP, normg + (l * 4 + 3) * DM, mod + (size_t)(l * 2 + 1) * 2 * 3072, H, normg + ((l + 1) * 4 + 0) * DM, mod + (size_t)((l + 1) * 2 + 0) * 2 * 3072, gw, NGW, lane);
        }
    }
}
__global__ void __launch_bounds__(512) fwd(Args a) {
    extern __shared__ __attribute__((aligned(16))) unsigned char lds_raw[];
    LAS unsigned char* lds = (LAS unsigned char*)lds_raw;
    cg::grid_group grid = cg::this_grid();
    const int lo = a.ph_lo, hi = a.ph_hi;
    volatile LAS unsigned* bst = (volatile LAS unsigned*)(lds + 131072 + 4096);
    if (threadIdx.x < 2) bst[threadIdx.x] = 0u;
    __syncthreads();
    XcdBarrier bar; bar.bar = (unsigned*)(a.ws + WS_BAR); bar.x = 0; bar.st = bst;
    if (hi - lo > 1) bar = xcd_barrier_post((unsigned*)(a.ws + WS_BAR), bst);
#define PHASE(k) if (lo <= (k) && (k) < hi) { run_phase<(k)>(a, lds); if ((k) + 1 < hi) { if (hi < 0) grid.sync(); else xcd_barrier(bar); } }
    PHASE(0) PHASE(1) PHASE(2) PHASE(4) PHASE(5) PHASE(6) PHASE(7) PHASE(8) PHASE(9) PHASE(10)
    PHASE(11) PHASE(13) PHASE(15) PHASE(16) PHASE(17) PHASE(18) PHASE(19)
#undef PHASE
}

extern "C" void kernel_launch(void* const* d_in, const int* in_sizes, int n_in, void* d_out, int out_size, void* d_ws, size_t ws_size, hipStream_t stream) {
    static int grid = 0;
    if (grid == 0) {
        if (n_in != 14 || in_sizes[0] != MROWS * DM || out_size != MROWS * DM || ws_size < WS_END) { fprintf(stderr, "kernel_launch: unexpected shapes / workspace (n_in %d, in0 %d, out %d, ws %zu); nothing launched\n", n_in, n_in > 0 ? in_sizes[0] : -1, out_size, ws_size); grid = -1; return; }
        int dev = 0, cus = 0, per_cu = 0;
        if (hipGetDevice(&dev) != hipSuccess || hipDeviceGetAttribute(&cus, hipDeviceAttributeMultiprocessorCount, dev) != hipSuccess) { fprintf(stderr, "kernel_launch: device query failed\n"); grid = -1; return; }
        if (hipFuncSetAttribute((const void*)fwd, hipFuncAttributeMaxDynamicSharedMemorySize, LDS_BYTES) != hipSuccess) { fprintf(stderr, "kernel_launch: hipFuncSetAttribute failed\n"); grid = -1; return; }
        if (hipOccupancyMaxActiveBlocksPerMultiprocessor(&per_cu, (const void*)fwd, 512, LDS_BYTES) != hipSuccess || per_cu < 1) { fprintf(stderr, "kernel_launch: occupancy query says %d\n", per_cu); per_cu = 1; }
        (void)hipGetLastError();
        grid = cus;
    }
    if (grid < 0) return;
    Args a{};
    for (int i = 0; i < 14; ++i) a.in[i] = (const float*)d_in[i];
    a.out = (float*)d_out; a.ws = (unsigned char*)d_ws;
#if MK_SINGLE
    a.ph_lo = 0; a.ph_hi = NPHASE;
    if (hipMemsetAsync((unsigned char*)d_ws + WS_BAR, 0, XCD_BAR_WORDS * 4, stream) != hipSuccess) { fprintf(stderr, "kernel_launch: memset of the barrier words failed\n"); return; }
    void* args[] = {&a};
    hipError_t e = hipLaunchCooperativeKernel((const void*)fwd, dim3(grid), dim3(512), args, LDS_BYTES, stream);
    if (e != hipSuccess) fprintf(stderr, "kernel_launch: cooperative launch failed: %s (grid %d)\n", hipGetErrorString(e), grid);
#else
    for (int ph = 0; ph < NPHASE; ++ph) {
        if (phase_empty(ph)) continue;
        a.ph_lo = ph; a.ph_hi = ph + 1;
        hipLaunchKernelGGL(fwd, dim3(grid), dim3(512), LDS_BYTES, stream, a);
    }
#endif
}
```
